# Optimizing an MI355X kernel written in HIP

```python
import jax, jax.numpy as jnp
from jax import lax
import numpy as np

D_MODEL = 1024
BATCH = 8
SEQ = 2048
DEPTH = 1

D_MIX = D_MODEL
D_RG = D_MIX // 2
D_ML = D_MIX - D_RG
RG_BLOCKS = 8
RG_BLOCK_DIM = D_RG // RG_BLOCKS
RG_C = 8.0
ML_HEADS = 4
ML_HEAD_DIM = D_ML // ML_HEADS
ML_CHUNK = 64
CONV_WIDTH = 4
D_FF = 4 * D_MODEL
EPS = 1e-6
SPLIT_SIZES = (D_RG, D_RG, D_ML, D_ML, D_ML, D_ML, ML_HEADS, ML_HEADS)
D_IN = sum(SPLIT_SIZES)

kernel_name = "hymba_rglru_mlstm_sandwich_layer"


def rmsnorm(x, g):
    xf = x.astype(jnp.float32)
    y = xf * lax.rsqrt(jnp.mean(xf * xf, axis=-1, keepdims=True) + EPS) * g.astype(jnp.float32)
    return y.astype(x.dtype)


def causal_depthwise_conv(x, w, b):
    c = x.shape[-1]
    y = lax.conv_general_dilated(
        x, w[:, None, :].astype(x.dtype), window_strides=(1,),
        padding=[(CONV_WIDTH - 1, 0)], dimension_numbers=("NWC", "WIO", "NWC"),
        feature_group_count=c)
    return y + b.astype(x.dtype)


def rg_lru(x, gate_r_w, gate_r_b, gate_i_w, gate_i_b, lam):
    bsz, s, _ = x.shape
    xf = x.astype(jnp.float32)
    xb = xf.reshape(bsz, s, RG_BLOCKS, RG_BLOCK_DIM)
    r = jax.nn.sigmoid(jnp.einsum("bsgi,gij->bsgj", xb, gate_r_w.astype(jnp.float32)).reshape(bsz, s, D_RG)
                       + gate_r_b.astype(jnp.float32))
    i = jax.nn.sigmoid(jnp.einsum("bsgi,gij->bsgj", xb, gate_i_w.astype(jnp.float32)).reshape(bsz, s, D_RG)
                       + gate_i_b.astype(jnp.float32))
    log_a = -RG_C * r * jax.nn.softplus(-lam.astype(jnp.float32))
    a = jnp.exp(log_a)
    b_in = jnp.sqrt(-jnp.expm1(2.0 * log_a)) * (i * xf)

    def combine(c1, c2):
        a1, b1 = c1
        a2, b2 = c2
        return a1 * a2, a2 * b1 + b2

    _, h = lax.associative_scan(combine, (a, b_in), axis=1)
    return h


def mlstm_chunkwise(q, k, v, log_i, log_f):
    bsz, s, nh, dh = q.shape
    L = ML_CHUNK
    nc = s // L
    to_chunks = lambda t: t.reshape(bsz, nc, L, nh, dh).transpose(0, 3, 1, 2, 4)
    q = to_chunks(q) * (dh ** -0.5)
    k = to_chunks(k)
    v = to_chunks(v)
    log_i = log_i.reshape(bsz, nc, L, nh).transpose(0, 3, 1, 2)
    log_f = log_f.reshape(bsz, nc, L, nh).transpose(0, 3, 1, 2)
    bcum = jnp.cumsum(log_f, axis=-1)
    b_last = bcum[..., -1]

    w = b_last[..., None] - bcum + log_i
    m_loc = jnp.max(w, axis=-1)
    kw = jnp.exp(w - m_loc[..., None])
    c_loc = jnp.einsum("bhcl,bhcld,bhcle->bhcde", kw, k, v)
    n_loc = jnp.einsum("bhcl,bhcld->bhcd", kw, k)

    def step(carry, inp):
        c_st, n_st, m_st = carry
        c_l, n_l, m_l, bl = inp
        m_new = jnp.maximum(bl + m_st, m_l)
        s_old = jnp.exp(bl + m_st - m_new)
        s_new = jnp.exp(m_l - m_new)
        c_new = s_old[..., None, None] * c_st + s_new[..., None, None] * c_l
        n_new = s_old[..., None] * n_st + s_new[..., None] * n_l
        return (c_new, n_new, m_new), (c_st, n_st, m_st)

    init = (jnp.zeros((bsz, nh, dh, dh), jnp.float32),
            jnp.zeros((bsz, nh, dh), jnp.float32),
            jnp.zeros((bsz, nh), jnp.float32))
    xs = (c_loc.transpose(2, 0, 1, 3, 4), n_loc.transpose(2, 0, 1, 3),
          m_loc.transpose(2, 0, 1), b_last.transpose(2, 0, 1))
    _, (c_prev, n_prev, m_prev) = lax.scan(step, init, xs)
    c_prev = c_prev.transpose(1, 2, 0, 3, 4)
    n_prev = n_prev.transpose(1, 2, 0, 3)
    m_prev = m_prev.transpose(1, 2, 0)

    d_mat = bcum[..., :, None] - bcum[..., None, :] + log_i[..., None, :]
    causal = jnp.tril(jnp.ones((L, L), dtype=bool))
    d_mat = jnp.where(causal, d_mat, -jnp.inf)
    inter_log = bcum + m_prev[..., None]
    m_s = jnp.maximum(inter_log, jnp.max(d_mat, axis=-1))
    p = jnp.exp(d_mat - m_s[..., None])
    scores = jnp.einsum("bhcsd,bhcjd->bhcsj", q, k) * p
    inter_w = jnp.exp(inter_log - m_s)
    num = (jnp.einsum("bhcsj,bhcje->bhcse", scores, v)
           + inter_w[..., None] * jnp.einsum("bhcsd,bhcde->bhcse", q, c_prev))
    den = jnp.sum(scores, axis=-1) + inter_w * jnp.einsum("bhcsd,bhcd->bhcs", q, n_prev)
    h = num / jnp.maximum(jnp.abs(den), jnp.exp(-m_s))[..., None]
    return h.transpose(0, 2, 3, 1, 4).reshape(bsz, s, nh, dh)


def hybrid_mixer(u, w_in, rg_conv_w, rg_conv_b, rg_gate_r_w, rg_gate_r_b, rg_gate_i_w, rg_gate_i_b,
                 rg_lambda, ml_conv_w, ml_conv_b, ml_igate_b, ml_fgate_b, rg_out_gain, ml_out_gain, w_out):
    bsz, s, _ = u.shape
    proj = jnp.einsum("bsd,de->bse", u, w_in.astype(u.dtype))
    idx = np.cumsum(SPLIT_SIZES)[:-1].tolist()
    rg_x, rg_gate, ml_q, ml_k, ml_v, ml_o, ml_i, ml_f = jnp.split(proj, idx, axis=-1)

    rg_xc = causal_depthwise_conv(rg_x, rg_conv_w, rg_conv_b)
    h_rg = rg_lru(rg_xc, rg_gate_r_w, rg_gate_r_b, rg_gate_i_w, rg_gate_i_b, rg_lambda)
    y_rg = rmsnorm(h_rg * jax.nn.gelu(rg_gate.astype(jnp.float32)), rg_out_gain)

    qk = jax.nn.silu(causal_depthwise_conv(jnp.concatenate([ml_q, ml_k], axis=-1), ml_conv_w, ml_conv_b))
    q, k = jnp.split(qk.astype(jnp.float32), 2, axis=-1)
    hd = (bsz, s, ML_HEADS, ML_HEAD_DIM)
    log_i = ml_i.astype(jnp.float32) + ml_igate_b.astype(jnp.float32)
    log_f = jax.nn.log_sigmoid(ml_f.astype(jnp.float32) + ml_fgate_b.astype(jnp.float32))
    h_ml = mlstm_chunkwise(q.reshape(hd), k.reshape(hd), ml_v.astype(jnp.float32).reshape(hd), log_i, log_f)
    h_ml = jax.nn.sigmoid(ml_o.astype(jnp.float32)).reshape(hd) * h_ml
    y_ml = rmsnorm(h_ml, ml_out_gain.reshape(ML_HEADS, ML_HEAD_DIM)).reshape(bsz, s, D_ML)

    y = jnp.concatenate([y_rg, y_ml], axis=-1).astype(u.dtype)
    return jnp.einsum("bse,ed->bsd", y, w_out.astype(u.dtype))


def setup_inputs(seed: int = 0) -> dict:
    key = jax.random.key(seed)
    ks = jax.random.split(key, 24)
    f32 = jnp.float32
    nrm = lambda k, shape, scale: jax.random.normal(k, shape, f32) * scale
    gain = lambda k, shape: 1.0 + 0.02 * jax.random.normal(k, shape, f32)
    u = jax.random.uniform(ks[9], (DEPTH, D_RG), f32, 0.9, 0.999)
    p = u ** (1.0 / RG_C)
    rg_lambda = jnp.log(p) - jnp.log1p(-p)
    ml_fgate_b = jnp.linspace(3.0, 6.0, ML_HEADS, dtype=f32)[None, :] + nrm(ks[13], (DEPTH, ML_HEADS), 0.1)
    return {
        "x": jax.random.normal(ks[0], (BATCH, SEQ, D_MODEL), f32),
        "pre_mix_gain": gain(ks[1], (DEPTH, D_MODEL)),
        "w_in": nrm(ks[2], (DEPTH, D_MODEL, D_IN), D_MODEL ** -0.5),
        "rg_conv_w": nrm(ks[3], (DEPTH, CONV_WIDTH, D_RG), CONV_WIDTH ** -0.5),
        "rg_conv_b": nrm(ks[4], (DEPTH, D_RG), 0.02),
        "rg_gate_r_w": nrm(ks[5], (DEPTH, RG_BLOCKS, RG_BLOCK_DIM, RG_BLOCK_DIM), RG_BLOCK_DIM ** -0.5),
        "rg_gate_r_b": nrm(ks[6], (DEPTH, D_RG), 0.02),
        "rg_gate_i_w": nrm(ks[7], (DEPTH, RG_BLOCKS, RG_BLOCK_DIM, RG_BLOCK_DIM), RG_BLOCK_DIM ** -0.5),
        "rg_gate_i_b": nrm(ks[8], (DEPTH, D_RG), 0.02),
        "rg_lambda": rg_lambda,
        "ml_conv_w": nrm(ks[10], (DEPTH, CONV_WIDTH, 2 * D_ML), CONV_WIDTH ** -0.5),
        "ml_conv_b": nrm(ks[11], (DEPTH, 2 * D_ML), 0.02),
        "ml_igate_b": nrm(ks[12], (DEPTH, ML_HEADS), 0.1),
        "ml_fgate_b": ml_fgate_b,
        "rg_out_gain": gain(ks[14], (DEPTH, D_RG)),
        "ml_out_gain": gain(ks[15], (DEPTH, D_ML)),
        "w_out": nrm(ks[16], (DEPTH, D_MIX, D_MODEL), D_MIX ** -0.5),
        "post_mix_gain": gain(ks[17], (DEPTH, D_MODEL)),
        "pre_mlp_gain": gain(ks[18], (DEPTH, D_MODEL)),
        "mlp_w_up": nrm(ks[19], (DEPTH, D_MODEL, D_FF), D_MODEL ** -0.5),
        "mlp_w_down": nrm(ks[20], (DEPTH, D_FF, D_MODEL), D_FF ** -0.5),
        "post_mlp_gain": gain(ks[21], (DEPTH, D_MODEL)),
    }


def reference(x, pre_mix_gain, w_in, rg_conv_w, rg_conv_b, rg_gate_r_w, rg_gate_r_b, rg_gate_i_w,
              rg_gate_i_b, rg_lambda, ml_conv_w, ml_conv_b, ml_igate_b, ml_fgate_b, rg_out_gain,
              ml_out_gain, w_out, post_mix_gain, pre_mlp_gain, mlp_w_up, mlp_w_down, post_mlp_gain):
    h = x
    for l in range(DEPTH):
        u = rmsnorm(h, pre_mix_gain[l])
        mix = hybrid_mixer(u, w_in[l], rg_conv_w[l], rg_conv_b[l], rg_gate_r_w[l], rg_gate_r_b[l],
                           rg_gate_i_w[l], rg_gate_i_b[l], rg_lambda[l], ml_conv_w[l], ml_conv_b[l],
                           ml_igate_b[l], ml_fgate_b[l], rg_out_gain[l], ml_out_gain[l], w_out[l])
        h = h + rmsnorm(mix, post_mix_gain[l])
        v = rmsnorm(h, pre_mlp_gain[l])
        ff = jnp.square(jax.nn.relu(jnp.einsum("bsd,df->bsf", v, mlp_w_up[l].astype(v.dtype))))
        ff = jnp.einsum("bsf,fd->bsd", ff, mlp_w_down[l].astype(v.dtype))
        h = h + rmsnorm(ff, post_mlp_gain[l])
    return h
```

```cpp
#include <hip/hip_runtime.h>
#include <hip/hip_cooperative_groups.h>
#include <cstdio>
#include <cstdint>
namespace cg = cooperative_groups;
namespace pg8 {
#define PG8_LAS __attribute__((address_space(3)))
typedef unsigned short bf16_t;
typedef short bf16x8 __attribute__((ext_vector_type(8)));
typedef float f32x4 __attribute__((ext_vector_type(4)));
typedef unsigned u32x4 __attribute__((ext_vector_type(4)));
constexpr int BM = 256, BK = 64, HALF = 128, HTB = HALF * BK * 2  , STAGE_BYTES = 8 * HTB, NXCD = 8, WGM = 8;

__host__ __device__ __forceinline__ int lds_byte(int r, int c) { const int st = (r >> 4) * 2 + (c >> 5), rr = r & 15, cc = c & 31, ob = rr * 64 + cc * 2; return st * 1024 + (ob ^ (((ob >> 9) & 1) << 5)); }
__host__ __device__ __forceinline__ void stage_rc(int b, int& R, int& C) { const int st = b / 1024, sb = b % 1024, swz = sb ^ (((sb >> 9) & 1) << 5); R = (st >> 1) * 16 + swz / 64; C = (st & 1) * 32 + (swz % 64) / 2; }
__host__ __device__ __forceinline__ int perm32(int rho) { const int n = rho >> 4, i = rho & 15; return 8 * (i >> 2) + 4 * n + (i & 3); }

struct Unit { int pm, pn; };
struct Gemm { const bf16_t* A; const bf16_t* Bt; int M, N, K; };

struct StaticOrder {
    int nM, nN, nwg, G, c;
    __host__ __device__ void init(int M, int N, int G_, int c_) { nM = M / BM; nN = N / BM; nwg = nM * nN; G = G_; c = c_; }
    __host__ __device__ bool next(int i, Unit& u) const {
        const long L = (long)i * G + c; if (L >= nwg) return false;
        int wgid = (int)L; { const int q = nwg / NXCD, r = nwg % NXCD, xcd = wgid % NXCD, off = wgid / NXCD; wgid = (xcd < r ? xcd * (q + 1) : r * (q + 1) + (xcd - r) * q) + off; }
        const int nig = WGM * nN, gid = wgid / nig, fm = gid * WGM, gsz = (nM - fm) < WGM ? (nM - fm) : WGM;
        u.pm = fm + ((wgid % nig) % gsz); u.pn = (wgid % nig) / gsz; return true;
    }
    __device__ __forceinline__ void a_ready(const Unit&) const {}
    __device__ __forceinline__ void done(const Unit&) const {}
};

__device__ __forceinline__ unsigned cvt_pk_bf16(float lo, float hi) { unsigned r; asm volatile("v_cvt_pk_bf16_f32 %0, %1, %2" : "=v"(r) : "v"(lo), "v"(hi)); return r; }
template <int ACT> struct EpiBf16 {
    static constexpr bool PERM = true, AFTER_DRAIN = false;
    bf16_t* O; int ldc;
    __device__ __forceinline__ void operator()(const f32x4 (&acc)[2][2][4][2], const Unit& u, int wr, int wc, int fr, int fq) const {
        const int row0 = u.pm * BM + wr * 64 + fr; const int col0 = u.pn * BM + wc * 32 + 8 * fq;
#pragma unroll
        for (int ai = 0; ai < 2; ++ai)
#pragma unroll
            for (int m = 0; m < 4; ++m) { bf16_t* rowp = O + (size_t)(row0 + ai * HALF + m * 16) * ldc + col0;
#pragma unroll
                for (int bj = 0; bj < 2; ++bj) { f32x4 v0 = acc[ai][bj][m][0], v1 = acc[ai][bj][m][1];
                    if (ACT == 2) {
#pragma unroll
                        for (int e = 0; e < 4; ++e) { float a = fmaxf(v0[e], 0.f), b = fmaxf(v1[e], 0.f); v0[e] = a * a; v1[e] = b * b; } }
                    u32x4 w; w.x = cvt_pk_bf16(v0[0], v0[1]); w.y = cvt_pk_bf16(v0[2], v0[3]); w.z = cvt_pk_bf16(v1[0], v1[1]); w.w = cvt_pk_bf16(v1[2], v1[3]);
                    *(u32x4*)(rowp + bj * HALF) = w; } }
    }
};
struct EpiF32 {
    static constexpr bool PERM = false, AFTER_DRAIN = false;
    float* O; int ldc;
    __device__ __forceinline__ void operator()(const f32x4 (&acc)[2][2][4][2], const Unit& u, int wr, int wc, int fr, int fq) const {
        const int col0 = u.pn * BM + wc * 32 + 4 * fq;
#pragma unroll
        for (int ai = 0; ai < 2; ++ai)
#pragma unroll
            for (int m = 0; m < 4; ++m) { const int r = u.pm * BM + ai * HALF + wr * 64 + m * 16 + fr; float* rowp = O + (size_t)r * ldc + col0;
#pragma unroll
                for (int bj = 0; bj < 2; ++bj)
#pragma unroll
                    for (int n = 0; n < 2; ++n) *(f32x4*)(rowp + bj * HALF + n * 16) = acc[ai][bj][m][n]; }
    }
};
template <class Epi, class Sched, bool ALIGN_EPI = false, bool SP2 = false>
__device__ __forceinline__ void gemm_phase(PG8_LAS unsigned char* lds, const Gemm g, const Sched& S, const Epi& E) {
    const int tid = threadIdx.x, wid = __builtin_amdgcn_readfirstlane(tid >> 6), lane = tid & 63, wr = wid >> 2, wc = wid & 3, fr = lane & 15, fq = lane >> 4;
    const int K = g.K, nt = K / BK;
    unsigned voffA[2], voffB[2];
#pragma unroll
    for (int i = 0; i < 2; ++i) { int R, C; stage_rc(tid * 16 + i * 8192, R, C); const int Rb = Epi::PERM ? ((R & ~31) + perm32(R & 31)) : R;
        voffA[i] = (unsigned)(R * K + C) * 2u; voffB[i] = (unsigned)(Rb * K + C) * 2u; }
    const size_t kstep = (size_t)(BK * 2);
    const size_t hstep = (size_t)HALF * K * 2;
    const size_t tstep = 2 * hstep;
    const unsigned ldsw = (unsigned)wid * 1024u;
    const int aoff = lds_byte(wr * 64 + fr, fq * 8), boff = lds_byte(wc * 32 + fr, fq * 8);
#define PG8_SA(b, h) (((b) * 2 + (h)) * HTB)
#define PG8_SB(b, h) ((4 + (b) * 2 + (h)) * HTB)
#define PG8_STAGE(bufoff, gbase, voff) do { _Pragma("unroll") for (int _i = 0; _i < 2; ++_i) \
        __builtin_amdgcn_global_load_lds((const unsigned*)((const char*)(gbase) + (voff)[_i]), (PG8_LAS unsigned*)(lds + (bufoff) + ldsw + _i * 8192), 16, 0, 0); } while (0)
#define PG8_LDA(dst, b, h) do { _Pragma("unroll") for (int m = 0; m < 4; ++m) _Pragma("unroll") for (int k = 0; k < 2; ++k) dst[m][k] = *(const PG8_LAS bf16x8*)(lds + PG8_SA(b, h) + aoff + m * 2048 + k * 1024); } while (0)
#define PG8_LDB(dst, b, h) do { _Pragma("unroll") for (int n = 0; n < 2; ++n) _Pragma("unroll") for (int k = 0; k < 2; ++k) dst[n][k] = *(const PG8_LAS bf16x8*)(lds + PG8_SB(b, h) + boff + n * 2048 + k * 1024); } while (0)
#define PG8_MMA(ai, bj, At, Bt) do { __builtin_amdgcn_s_setprio(1); _Pragma("unroll") for (int m = 0; m < 4; ++m) _Pragma("unroll") for (int n = 0; n < 2; ++n) _Pragma("unroll") for (int k = 0; k < 2; ++k) \
        acc[ai][bj][m][n] = __builtin_amdgcn_mfma_f32_16x16x32_bf16(Bt[n][k], At[m][k], acc[ai][bj][m][n], 0, 0, 0); __builtin_amdgcn_s_setprio(0); } while (0)
#define PG8_WAIT_V(n) asm volatile("s_waitcnt vmcnt(" #n ")" ::: "memory")
#define PG8_WAIT_L(n) asm volatile("s_waitcnt lgkmcnt(" #n ")" ::: "memory")
#define PG8_BAR __builtin_amdgcn_s_barrier()
#define PG8_SCHED __builtin_amdgcn_sched_barrier(0)
    Unit cur, nxt; int ui = 0;
    if (!S.next(0, cur)) return;
    f32x4 acc[2][2][4][2];
#pragma unroll
    for (int a = 0; a < 2; ++a)
#pragma unroll
        for (int b = 0; b < 2; ++b)
#pragma unroll
            for (int m = 0; m < 4; ++m)
#pragma unroll
                for (int n = 0; n < 2; ++n) acc[a][b][m][n] = (f32x4){0.f, 0.f, 0.f, 0.f};
    bf16x8 At[4][2], B0[2][2], B1[2][2];
    const char* cA = (const char*)g.A + (size_t)cur.pm * tstep; const char* cB = (const char*)g.Bt + (size_t)cur.pn * tstep;
    S.a_ready(cur);
    if constexpr (SP2) {
        PG8_STAGE(PG8_SB(0, 0), cB, voffB); PG8_STAGE(PG8_SB(0, 1), cB + hstep, voffB); PG8_STAGE(PG8_SA(0, 0), cA, voffA); PG8_STAGE(PG8_SA(0, 1), cA + hstep, voffA);
        if (wr == 1) PG8_BAR;
        PG8_WAIT_V(2); PG8_BAR;
        PG8_STAGE(PG8_SB(1, 0), cB + kstep, voffB); PG8_STAGE(PG8_SA(1, 0), cA + kstep, voffA); PG8_STAGE(PG8_SB(1, 1), cB + hstep + kstep, voffB);
        PG8_WAIT_V(6); PG8_BAR;
    } else {
        PG8_STAGE(PG8_SB(0, 0), cB, voffB); PG8_STAGE(PG8_SA(0, 0), cA, voffA); PG8_STAGE(PG8_SB(0, 1), cB + hstep, voffB); PG8_STAGE(PG8_SA(0, 1), cA + hstep, voffA);
        if (wr == 1) PG8_BAR;
        PG8_WAIT_V(4); PG8_BAR;
        PG8_STAGE(PG8_SB(1, 0), cB + kstep, voffB); PG8_STAGE(PG8_SA(1, 0), cA + kstep, voffA); PG8_STAGE(PG8_SB(1, 1), cB + hstep + kstep, voffB);
        PG8_WAIT_V(6); PG8_BAR;
    }
    for (;;) {
        const bool has_next = S.next(ui + 1, nxt);
        const char* nA = has_next ? (const char*)g.A + (size_t)nxt.pm * tstep : cA; const char* nB = has_next ? (const char*)g.Bt + (size_t)nxt.pn * tstep : cB;
        for (int t = 0; t < nt; t += 2) {
            const bool last = (t == nt - 2);
            const char* a1 = cA + (size_t)(t + 1) * kstep;
            const char* a2 = last ? nA : cA + (size_t)(t + 2) * kstep; const char* b2 = last ? nB : cB + (size_t)(t + 2) * kstep;
            const char* a3 = a2 + kstep; const char* b3 = b2 + kstep;
            if (last && has_next) S.a_ready(nxt);
            if constexpr (SP2) {
            PG8_LDB(B0, 0, 0); PG8_LDB(B1, 0, 1); PG8_SCHED; PG8_LDA(At, 0, 0); PG8_STAGE(PG8_SA(1, 1), a1 + hstep, voffA);
            PG8_WAIT_V(8); PG8_WAIT_L(0); PG8_BAR; PG8_MMA(0, 0, At, B0); PG8_MMA(0, 1, At, B1); PG8_BAR; PG8_SCHED;
            PG8_LDA(At, 0, 1); PG8_STAGE(PG8_SB(0, 0), b2, voffB); PG8_STAGE(PG8_SB(0, 1), b2 + hstep, voffB); PG8_STAGE(PG8_SA(0, 0), a2, voffA);
            PG8_WAIT_V(8); PG8_WAIT_L(0); PG8_BAR; PG8_MMA(1, 0, At, B0); PG8_MMA(1, 1, At, B1); PG8_BAR; PG8_SCHED;
            PG8_LDB(B0, 1, 0); PG8_LDB(B1, 1, 1); PG8_SCHED; PG8_LDA(At, 1, 0); PG8_STAGE(PG8_SA(0, 1), a2 + hstep, voffA);
            PG8_WAIT_V(8); PG8_WAIT_L(0); PG8_BAR; PG8_MMA(0, 0, At, B0); PG8_MMA(0, 1, At, B1); PG8_BAR; PG8_SCHED;
            PG8_LDA(At, 1, 1); PG8_STAGE(PG8_SB(1, 0), b3, voffB); PG8_STAGE(PG8_SB(1, 1), b3 + hstep, voffB); PG8_STAGE(PG8_SA(1, 0), a3, voffA);
            PG8_WAIT_V(8); PG8_WAIT_L(0); PG8_BAR; PG8_MMA(1, 0, At, B0); PG8_MMA(1, 1, At, B1); PG8_BAR; PG8_SCHED;
            } else {
            PG8_LDB(B0, 0, 0); PG8_SCHED; PG8_LDA(At, 0, 0); PG8_STAGE(PG8_SA(1, 1), a1 + hstep, voffA);
            PG8_WAIT_L(8); PG8_BAR; PG8_WAIT_L(0); PG8_MMA(0, 0, At, B0); PG8_BAR; PG8_SCHED;
            PG8_LDB(B1, 0, 1); PG8_STAGE(PG8_SB(0, 0), b2, voffB);
            PG8_BAR; PG8_WAIT_L(0); PG8_MMA(0, 1, At, B1); PG8_BAR;
            PG8_LDA(At, 0, 1); PG8_STAGE(PG8_SA(0, 0), a2, voffA);
            PG8_BAR; PG8_WAIT_L(0); PG8_MMA(1, 0, At, B0); PG8_BAR; PG8_SCHED;
            PG8_STAGE(PG8_SB(0, 1), b2 + hstep, voffB);
            PG8_WAIT_V(6); PG8_BAR; PG8_MMA(1, 1, At, B1); PG8_BAR;
            PG8_LDB(B0, 1, 0); PG8_SCHED; PG8_LDA(At, 1, 0); PG8_STAGE(PG8_SA(0, 1), a2 + hstep, voffA);
            PG8_WAIT_L(8); PG8_BAR; PG8_WAIT_L(0); PG8_MMA(0, 0, At, B0); PG8_BAR; PG8_SCHED;
            PG8_LDB(B1, 1, 1); PG8_STAGE(PG8_SB(1, 0), b3, voffB);
            PG8_BAR; PG8_WAIT_L(0); PG8_MMA(0, 1, At, B1); PG8_BAR;
            PG8_LDA(At, 1, 1); PG8_STAGE(PG8_SA(1, 0), a3, voffA);
            PG8_BAR; PG8_WAIT_L(0); PG8_MMA(1, 0, At, B0); PG8_BAR; PG8_SCHED;
            PG8_STAGE(PG8_SB(1, 1), b3 + hstep, voffB);
            PG8_WAIT_V(6); PG8_BAR; PG8_MMA(1, 1, At, B1); PG8_BAR;
            }
        }
        if constexpr (ALIGN_EPI) { if (wr == 0) PG8_BAR; }
        if constexpr (!Epi::AFTER_DRAIN) { E(acc, cur, wr, wc, fr, fq); S.done(cur); }
        if (!has_next) break;
#pragma unroll
        for (int a = 0; a < 2; ++a)
#pragma unroll
            for (int b = 0; b < 2; ++b)
#pragma unroll
                for (int m = 0; m < 4; ++m)
#pragma unroll
                    for (int n = 0; n < 2; ++n) acc[a][b][m][n] = (f32x4){0.f, 0.f, 0.f, 0.f};
        cur = nxt; cA = nA; cB = nB; ++ui;
        if constexpr (ALIGN_EPI) { if (wr == 1) PG8_BAR; }
    }
    PG8_WAIT_V(0);
    if constexpr (!ALIGN_EPI) { if (wr == 0) PG8_BAR; }
    PG8_BAR;
    if constexpr (Epi::AFTER_DRAIN) { E.fused(acc, cur, wr, wc, fr, fq, lds, wid, lane); S.done(cur); }
#undef PG8_SA
#undef PG8_SB
#undef PG8_STAGE
#undef PG8_LDA
#undef PG8_LDB
#undef PG8_MMA
#undef PG8_WAIT_V
#undef PG8_WAIT_L
#undef PG8_BAR
#undef PG8_SCHED
}
}

constexpr int NB = 8, SEQ = 2048, DM = 1024, MT = NB * SEQ, DIN = 3080, NPROJ = 3072, FF = 4096;
constexpr int NCH = 32, CL = 64, NH = 4, HD = 128, DRG = 512;
constexpr float EPS = 1e-6f;
constexpr int NWAVES = 8, NTHR = 512;
constexpr size_t MiB = 1u << 20;
constexpr size_t WS_WIN = 1 * MiB, WS_WO = 7 * MiB, WS_WUP = 9 * MiB, WS_WDN = 17 * MiB;
constexpr size_t WS_GATES = 25 * MiB;
constexpr size_t WS_RGA = 26 * MiB, WS_RGH = 26 * MiB + 512 * 1024, WS_RGIN = 27 * MiB;
constexpr size_t WS_MLOC = 28 * MiB, WS_BLAST = 28 * MiB + 65536, WS_MPREV = 28 * MiB + 131072;
constexpr size_t WS_XN = 32 * MiB;
constexpr size_t WS_PROJ = 64 * MiB;
constexpr size_t WS_CLOC = 160 * MiB;
constexpr size_t WS_H = 96 * MiB;
constexpr size_t WS_FFO = 32 * MiB;
constexpr int CITEM = 129 * 128;
constexpr int LDS_BYTES = 147456;

#define LAS __attribute__((address_space(3)))
typedef unsigned short bf16;
typedef unsigned v4u __attribute__((ext_vector_type(4)));
typedef unsigned v2u __attribute__((ext_vector_type(2)));
typedef float f32x4 __attribute__((ext_vector_type(4)));
#define LDS_WAIT() asm volatile("s_waitcnt lgkmcnt(0)" ::: "memory")
__device__ __forceinline__ unsigned f2bf(float f) { unsigned u = __builtin_bit_cast(unsigned, f); return (u + 0x7fffu + ((u >> 16) & 1u)) >> 16; }
__device__ __forceinline__ unsigned pk2(float lo, float hi) { return f2bf(lo) | (f2bf(hi) << 16); }
__device__ __forceinline__ float bf2f(bf16 u) { return __builtin_bit_cast(float, (unsigned)u << 16); }
__device__ __forceinline__ float wave_sum(float v) {
#pragma unroll
    for (int o = 1; o < 64; o <<= 1) v += __shfl_xor(v, o);
    return v;
}
__device__ __forceinline__ float wave_max(float v) {
#pragma unroll
    for (int o = 1; o < 64; o <<= 1) v = fmaxf(v, __shfl_xor(v, o));
    return v;
}
__device__ __forceinline__ float sigmoidf_(float z) { return 1.f / (1.f + __expf(-z)); }
__device__ __forceinline__ float logsigmoidf_(float z) { return fminf(z, 0.f) - log1pf(__expf(-fabsf(z))); }
__device__ __forceinline__ float gelu_tanh(float v) { const float u = 0.7978845608028654f * (v + 0.044715f * v * v * v); return 0.5f * v * (1.f + tanhf(u)); }
__device__ __forceinline__ float rdlane(float v, int l) { return __builtin_bit_cast(float, __builtin_amdgcn_readlane(__builtin_bit_cast(int, v), l)); }

struct Frame {
    LAS unsigned char* lds;
    int tid, lane, wave, G, bid;
    const float* in[22]; float* out; unsigned char* ws;
};

__device__ __forceinline__ void p0_transpose_item(const float* W, int K, int ldw, int nblk, bf16* WT, LAS float* scr, int item, int lane) {
    const int kb = item / nblk, nb = item % nblk, k0 = 64 * kb, n0 = 32 * nb;
#pragma unroll 8
    for (int i = 0; i < 32; ++i) { const int kk = 2 * i + (lane >> 5); scr[kk * 33 + (lane & 31)] = W[(size_t)(k0 + kk) * ldw + n0 + (lane & 31)]; }
    LDS_WAIT(); asm volatile("" ::: "memory");
    const int c = lane & 7;
#pragma unroll
    for (int j = 0; j < 4; ++j) { const int n = (lane >> 3) + 8 * j; const LAS float* s = scr + (8 * c) * 33 + n;
        v4u o; o.x = pk2(s[0 * 33], s[1 * 33]); o.y = pk2(s[2 * 33], s[3 * 33]); o.z = pk2(s[4 * 33], s[5 * 33]); o.w = pk2(s[6 * 33], s[7 * 33]);
        *(v4u*)(WT + (size_t)(n0 + n) * K + k0 + 8 * c) = o; }
    LDS_WAIT(); asm volatile("" ::: "memory");
}

__device__ __forceinline__ void p0_prologue(const Frame& F) {
    LAS float* scr = (LAS float*)(F.lds + F.wave * 16384);
    const int gw = F.bid * NWAVES + F.wave, NGW = F.G * NWAVES;
    constexpr int I_IN = (DM / 64) * (NPROJ / 32), I_O = (DM / 64) * (DM / 32), I_UP = (DM / 64) * (FF / 32), I_DN = (FF / 64) * (DM / 32);
    constexpr int NITEMS = I_IN + I_O + I_UP + I_DN;
    bf16* win_t = (bf16*)(F.ws + WS_WIN); bf16* wo_t = (bf16*)(F.ws + WS_WO); bf16* wup_t = (bf16*)(F.ws + WS_WUP); bf16* wdn_t = (bf16*)(F.ws + WS_WDN);
    for (int it = gw; it < NITEMS; it += NGW) {
        int r = it;
        if (r < I_IN) { p0_transpose_item(F.in[2], DM, DIN, NPROJ / 32, win_t, scr, r, F.lane); continue; } r -= I_IN;
        if (r < I_O) { p0_transpose_item(F.in[16], DM, DM, DM / 32, wo_t, scr, r, F.lane); continue; } r -= I_O;
        if (r < I_UP) { p0_transpose_item(F.in[19], DM, FF, FF / 32, wup_t, scr, r, F.lane); continue; } r -= I_UP;
        p0_transpose_item(F.in[20], FF, DM, DM / 32, wdn_t, scr, r, F.lane);
    }
    __syncthreads();
    LAS float* wg = (LAS float*)F.lds;
    for (int e = F.tid; e < 8 * DM; e += NTHR) { const int k = e >> 3, n = e & 7; wg[n * DM + k] = F.in[2][(size_t)k * DIN + NPROJ + n]; }
    __syncthreads();
    const float* x = F.in[0]; bf16* xn = (bf16*)(F.ws + WS_XN); float* gates = (float*)(F.ws + WS_GATES);
    f32x4 gn[4];
#pragma unroll
    for (int j = 0; j < 4; ++j) gn[j] = *(const f32x4*)(F.in[1] + 256 * j + 4 * F.lane);
    for (int m = gw; m < MT; m += NGW) {
        const f32x4* xr = (const f32x4*)(x + (size_t)m * DM) + F.lane;
        f32x4 v[4]; float s = 0.f;
#pragma unroll
        for (int j = 0; j < 4; ++j) { v[j] = xr[64 * j]; s += (v[j].x * v[j].x + v[j].y * v[j].y) + (v[j].z * v[j].z + v[j].w * v[j].w); }
        const float rstd = rsqrtf(wave_sum(s) * (1.f / DM) + EPS);
        unsigned long long* o8 = (unsigned long long*)(xn + (size_t)m * DM) + F.lane;
        float ga[8];
#pragma unroll
        for (int n = 0; n < 8; ++n) ga[n] = 0.f;
#pragma unroll
        for (int j = 0; j < 4; ++j) {
            v[j] = v[j] * rstd * gn[j];
            o8[64 * j] = (unsigned long long)pk2(v[j].x, v[j].y) | ((unsigned long long)pk2(v[j].z, v[j].w) << 32);
#pragma unroll
            for (int n = 0; n < 8; ++n) { const f32x4 w = *(const LAS f32x4*)(wg + n * DM + 256 * j + 4 * F.lane);
                ga[n] += (v[j].x * w.x + v[j].y * w.y) + (v[j].z * w.z + v[j].w * w.w); }
        }
#pragma unroll
        for (int n = 0; n < 8; ++n) ga[n] = wave_sum(ga[n]);
        if (F.lane == 0) { *(f32x4*)(gates + (size_t)m * 8) = (f32x4){ga[0], ga[1], ga[2], ga[3]}; *(f32x4*)(gates + (size_t)m * 8 + 4) = (f32x4){ga[4], ga[5], ga[6], ga[7]}; }
    }
    __syncthreads();
}

template <bool FINAL>
__device__ __forceinline__ void rg_pass(const Frame& F, int b, int ch) {
    const int c = F.tid, g = c >> 6, j = c & 63;
    float wr[64], wi[64];
    const float* pwr = F.in[5]; const float* pwi = F.in[7]; asm volatile("" : "+s"(pwr), "+s"(pwi));
#pragma unroll
    for (int i = 0; i < 64; ++i) { wr[i] = pwr[(g * 64 + i) * 64 + j]; wi[i] = pwi[(g * 64 + i) * 64 + j]; }
    const float cw0 = F.in[3][c], cw1 = F.in[3][DRG + c], cw2 = F.in[3][2 * DRG + c], cw3 = F.in[3][3 * DRG + c], cb = F.in[4][c];
    const float br = F.in[6][c], bi = F.in[8][c];
    const float zl = -F.in[9][c];
    const float sp8 = 8.f * (fmaxf(zl, 0.f) + log1pf(__expf(-fabsf(zl))));
    const bf16* proj = (const bf16*)(F.ws + WS_PROJ);
    const bf16* px = proj + (size_t)(b * SEQ + ch * CL) * NPROJ + c;
    const bf16* pg = px + DRG;
    float x0 = 0.f, x1 = 0.f, x2 = 0.f;
    if (ch > 0) { x0 = bf2f(*(px - 3 * NPROJ)); x1 = bf2f(*(px - 2 * NPROJ)); x2 = bf2f(*(px - NPROJ)); }
    float h = 0.f, Ap = 1.f;
    if (FINAL) h = ((const float*)(F.ws + WS_RGIN))[(b * NCH + ch) * DRG + c];
    LAS float* val = (LAS float*)F.lds;
    bf16 xr[8], gr[8];
#pragma unroll
    for (int u = 0; u < 8; ++u) { xr[u] = px[(size_t)u * NPROJ]; gr[u] = FINAL ? pg[(size_t)u * NPROJ] : (bf16)0; }
#pragma unroll 1
    for (int tb = 0; tb < 8; ++tb) {
        bf16 xc_[8], gc_[8];
#pragma unroll
        for (int u = 0; u < 8; ++u) { xc_[u] = xr[u]; gc_[u] = gr[u]; }
        if (tb < 7) {
#pragma unroll
            for (int u = 0; u < 8; ++u) { xr[u] = px[(size_t)(tb * 8 + 8 + u) * NPROJ]; if (FINAL) gr[u] = pg[(size_t)(tb * 8 + 8 + u) * NPROJ]; }
        }
#pragma unroll
        for (int u = 0; u < 8; ++u) {
            const float x3 = bf2f(xc_[u]);
            const float xc = cb + cw0 * x0 + cw1 * x1 + cw2 * x2 + cw3 * x3;
            x0 = x1; x1 = x2; x2 = x3;
            float rp = br, ip = bi;
#pragma unroll
            for (int i = 0; i < 64; ++i) { const float xi = rdlane(xc, i); rp += xi * wr[i]; ip += xi * wi[i]; }
            const float r = sigmoidf_(rp), ig = sigmoidf_(ip);
            const float la = -sp8 * r;
            const float a = __expf(la);
            const float bb = sqrtf(-expm1f(2.f * la)) * (ig * xc);
            h = a * h + bb;
            if (!FINAL) Ap *= a;
            else val[(tb * 8 + u) * DRG + c] = h * gelu_tanh(bf2f(gc_[u]));
            __builtin_amdgcn_sched_barrier(0);
        }
    }
    if (!FINAL) {
        ((float*)(F.ws + WS_RGA))[(b * NCH + ch) * DRG + c] = Ap;
        ((float*)(F.ws + WS_RGH))[(b * NCH + ch) * DRG + c] = h;
    } else {
        __syncthreads();
        bf16* Y = (bf16*)(F.ws + WS_XN);
        const f32x4 g0 = *(const f32x4*)(F.in[14] + 8 * F.lane), g1 = *(const f32x4*)(F.in[14] + 8 * F.lane + 4);
#pragma unroll 2
        for (int tt = 0; tt < 8; ++tt) {
            const int t = F.wave * 8 + tt;
            const f32x4 a0 = *(const LAS f32x4*)(val + t * DRG + 8 * F.lane), a1 = *(const LAS f32x4*)(val + t * DRG + 8 * F.lane + 4);
            float s = (a0.x * a0.x + a0.y * a0.y) + (a0.z * a0.z + a0.w * a0.w) + (a1.x * a1.x + a1.y * a1.y) + (a1.z * a1.z + a1.w * a1.w);
            const float rstd = rsqrtf(wave_sum(s) * (1.f / DRG) + EPS);
            const f32x4 y0 = a0 * rstd * g0, y1 = a1 * rstd * g1;
            v4u o; o.x = pk2(y0.x, y0.y); o.y = pk2(y0.z, y0.w); o.z = pk2(y1.x, y1.y); o.w = pk2(y1.z, y1.w);
            *(v4u*)(Y + (size_t)(b * SEQ + ch * CL + t) * DM + 8 * F.lane) = o;
        }
        __syncthreads();
    }
}

constexpr int LP = 132;
template <bool CONV, bool KW>
__device__ __forceinline__ void ml_stage(const Frame& F, int b, int ch, int col0, int cc0, float scl, const LAS float* kw, LAS float* dst) {
    const int d = F.tid & 127, tq = F.tid >> 7;
    const bf16* proj = (const bf16*)(F.ws + WS_PROJ);
    const bf16* p = proj + (size_t)(b * SEQ + ch * CL + 16 * tq) * NPROJ + col0 + d;
    bf16 raw[19];
    const bool has_halo = (ch > 0) || (tq > 0);
#pragma unroll
    for (int u = 0; u < 16; ++u) raw[3 + u] = p[(size_t)u * NPROJ];
    if (CONV) {
#pragma unroll
        for (int u = 0; u < 3; ++u) raw[u] = has_halo ? *(p - (size_t)(3 - u) * NPROJ) : (bf16)0;
        const float w0 = F.in[10][cc0 + d], w1 = F.in[10][DM + cc0 + d], w2 = F.in[10][2 * DM + cc0 + d], w3 = F.in[10][3 * DM + cc0 + d], bb = F.in[11][cc0 + d];
#pragma unroll
        for (int u = 0; u < 16; ++u) {
            float v = bb + w0 * bf2f(raw[u]) + w1 * bf2f(raw[u + 1]) + w2 * bf2f(raw[u + 2]) + w3 * bf2f(raw[u + 3]);
            v = v * sigmoidf_(v) * scl;
            if (KW) v *= kw[16 * tq + u];
            dst[(16 * tq + u) * LP + d] = v;
        }
    } else {
#pragma unroll
        for (int u = 0; u < 16; ++u) dst[(16 * tq + u) * LP + d] = bf2f(raw[3 + u]);
    }
}

constexpr int L_A = 0, L_B = 64 * LP, L_C = 2 * 64 * LP, L_S = 3 * 64 * LP, SP = 68, L_SM = L_S + 64 * SP;
static_assert((L_SM + 1024) * 4 <= 131072, "lds");

__device__ __forceinline__ void ml_local(const Frame& F, int b, int ch, int hh) {
    LAS float* L = (LAS float*)F.lds;
    LAS float* KS = L + L_A; LAS float* VS = L + L_B; LAS float* kw = L + L_SM;
    const float* gates = (const float*)(F.ws + WS_GATES);
    const int item = (b * NH + hh) * NCH + ch;
    if (F.wave == 0) {
        const int m = b * SEQ + ch * CL + F.lane;
        const float li = gates[(size_t)m * 8 + hh] + F.in[12][hh];
        const float lf = logsigmoidf_(gates[(size_t)m * 8 + 4 + hh] + F.in[13][hh]);
        float bc = lf;
#pragma unroll
        for (int o = 1; o < 64; o <<= 1) { const float t = __shfl_up(bc, o); if (F.lane >= o) bc += t; }
        const float blast = __shfl(bc, 63);
        const float w = blast - bc + li;
        const float mloc = wave_max(w);
        kw[F.lane] = __expf(w - mloc);
        if (F.lane == 0) { ((float*)(F.ws + WS_MLOC))[item] = mloc; ((float*)(F.ws + WS_BLAST))[item] = blast; }
    }
    __syncthreads();
    ml_stage<true, true>(F, b, ch, 1536 + hh * HD, 512 + hh * HD, 1.f, kw, KS);
    ml_stage<false, false>(F, b, ch, 2048 + hh * HD, 0, 1.f, kw, VS);
    __syncthreads();
    const int db = F.tid >> 5, eb = F.tid & 31;
    f32x4 acc[8];
#pragma unroll
    for (int i = 0; i < 8; ++i) acc[i] = (f32x4){0.f, 0.f, 0.f, 0.f};
#pragma unroll 4
    for (int t = 0; t < 64; ++t) {
        const f32x4 k0 = *(const LAS f32x4*)(KS + t * LP + 8 * db), k1 = *(const LAS f32x4*)(KS + t * LP + 8 * db + 4);
        const f32x4 v = *(const LAS f32x4*)(VS + t * LP + 4 * eb);
        acc[0] += k0.x * v; acc[1] += k0.y * v; acc[2] += k0.z * v; acc[3] += k0.w * v;
        acc[4] += k1.x * v; acc[5] += k1.y * v; acc[6] += k1.z * v; acc[7] += k1.w * v;
    }
    float* base = (float*)(F.ws + WS_CLOC) + (size_t)item * CITEM;
#pragma unroll
    for (int i = 0; i < 8; ++i) *(f32x4*)(base + (8 * db + i) * HD + 4 * eb) = acc[i];
    if (F.tid < HD) { float s = 0.f;
#pragma unroll 8
        for (int t = 0; t < 64; ++t) s += KS[t * LP + F.tid];
        base[HD * HD + F.tid] = s; }
    __syncthreads();
}

__device__ __forceinline__ void scan_phase(const Frame& F) {
    LAS float* L = (LAS float*)F.lds;
    LAS float* so = L; LAS float* sn = L + 1024;
    if (F.tid < 32) {
        const int bh = F.tid; float m = 0.f;
        const float* mloc = (const float*)(F.ws + WS_MLOC); const float* blast = (const float*)(F.ws + WS_BLAST); float* mprev = (float*)(F.ws + WS_MPREV);
        for (int c = 0; c < NCH; ++c) {
            const float ml = mloc[bh * NCH + c], bl = blast[bh * NCH + c];
            const float mn = fmaxf(bl + m, ml);
            so[bh * NCH + c] = __expf(bl + m - mn); sn[bh * NCH + c] = __expf(ml - mn);
            if (F.bid == 0) mprev[bh * NCH + c] = m;
            m = mn;
        }
    }
    __syncthreads();
    const int gt = F.bid * NTHR + F.tid, NGT = F.G * NTHR;
    constexpr int V4_PER_BH = CITEM / 4;
    for (int idx = gt; idx < 32 * V4_PER_BH; idx += NGT) {
        const int bh = idx / V4_PER_BH, off = idx % V4_PER_BH;
        f32x4* p = (f32x4*)((float*)(F.ws + WS_CLOC) + (size_t)bh * NCH * CITEM) + off;
        f32x4 st = (f32x4){0.f, 0.f, 0.f, 0.f};
#pragma unroll 8
        for (int c = 0; c < NCH; ++c) {
            const f32x4 cl = p[(size_t)c * V4_PER_BH];
            p[(size_t)c * V4_PER_BH] = st;
            st = so[bh * NCH + c] * st + sn[bh * NCH + c] * cl;
        }
    }
    if (gt < NB * DRG) {
        const int b = gt / DRG, c = gt % DRG;
        const float* A = (const float*)(F.ws + WS_RGA); const float* H = (const float*)(F.ws + WS_RGH); float* HI = (float*)(F.ws + WS_RGIN);
        float h = 0.f;
#pragma unroll 8
        for (int k = 0; k < NCH; ++k) { const int o = (b * NCH + k) * DRG + c; const float a = A[o], hh = H[o]; HI[o] = h; h = a * h + hh; }
    }
    __syncthreads();
}

__device__ __forceinline__ void ml_out(const Frame& F, int b, int ch, int hh) {
    LAS float* L = (LAS float*)F.lds;
    LAS float* QS = L + L_A; LAS float* KS = L + L_B; LAS float* VS = L + L_C; LAS float* SS = L + L_S;
    LAS float* s_bc = L + L_SM; LAS float* s_li = s_bc + 64; LAS float* s_ms = s_bc + 128; LAS float* s_iw = s_bc + 192; LAS float* s_den = s_bc + 256;
    const float* gates = (const float*)(F.ws + WS_GATES);
    const int item = (b * NH + hh) * NCH + ch;
    const float mprev = ((const float*)(F.ws + WS_MPREV))[item];
    const float* cprev = (const float*)(F.ws + WS_CLOC) + (size_t)item * CITEM;
    if (F.wave == 0) {
        const int m = b * SEQ + ch * CL + F.lane;
        const float li = gates[(size_t)m * 8 + hh] + F.in[12][hh];
        const float lf = logsigmoidf_(gates[(size_t)m * 8 + 4 + hh] + F.in[13][hh]);
        float bc = lf;
#pragma unroll
        for (int o = 1; o < 64; o <<= 1) { const float t = __shfl_up(bc, o); if (F.lane >= o) bc += t; }
        float gm = li - bc;
#pragma unroll
        for (int o = 1; o < 64; o <<= 1) { const float t = __shfl_up(gm, o); if (F.lane >= o) gm = fmaxf(gm, t); }
        const float ms = bc + fmaxf(mprev, gm);
        s_bc[F.lane] = bc; s_li[F.lane] = li; s_ms[F.lane] = ms; s_iw[F.lane] = __expf(bc + mprev - ms);
    }
    ml_stage<true, false>(F, b, ch, 1024 + hh * HD, hh * HD, 0.08838834764831845f, s_bc, QS);
    ml_stage<true, false>(F, b, ch, 1536 + hh * HD, 512 + hh * HD, 1.f, s_bc, KS);
    ml_stage<false, false>(F, b, ch, 2048 + hh * HD, 0, 1.f, s_bc, VS);
    __syncthreads();
    {
        const int j = F.lane, s0 = 8 * F.wave;
        float acc[8];
#pragma unroll
        for (int i = 0; i < 8; ++i) acc[i] = 0.f;
#pragma unroll 4
        for (int d4 = 0; d4 < 32; ++d4) {
            const f32x4 kv = *(const LAS f32x4*)(KS + j * LP + 4 * d4);
#pragma unroll
            for (int i = 0; i < 8; ++i) { const f32x4 q = *(const LAS f32x4*)(QS + (s0 + i) * LP + 4 * d4); acc[i] += (q.x * kv.x + q.y * kv.y) + (q.z * kv.z + q.w * kv.w); }
        }
        const float bj = s_bc[j], lj = s_li[j];
        const float np0 = cprev[HD * HD + j], np1 = cprev[HD * HD + 64 + j];
#pragma unroll
        for (int i = 0; i < 8; ++i) {
            const int s = s0 + i;
            const float p = (j <= s) ? __expf(s_bc[s] - bj + lj - s_ms[s]) : 0.f;
            const float sc = acc[i] * p;
            SS[s * SP + j] = sc;
            const float rs = wave_sum(sc);
            const float qn = wave_sum(QS[s * LP + j] * np0 + QS[s * LP + 64 + j] * np1);
            if (j == 0) s_den[s] = rs + s_iw[s] * qn;
        }
    }
    __syncthreads();
    {
        const int sb = F.tid >> 5, eb = F.tid & 31;
        f32x4 a1[4], a2[4];
#pragma unroll
        for (int i = 0; i < 4; ++i) { a1[i] = (f32x4){0.f, 0.f, 0.f, 0.f}; a2[i] = (f32x4){0.f, 0.f, 0.f, 0.f}; }
        const int jmax = 4 * sb + 3;
        for (int j = 0; j <= jmax; ++j) {
            const f32x4 v = *(const LAS f32x4*)(VS + j * LP + 4 * eb);
#pragma unroll
            for (int i = 0; i < 4; ++i) a1[i] += SS[(4 * sb + i) * SP + j] * v;
        }
#pragma unroll 2
        for (int d4 = 0; d4 < 32; ++d4) {
            f32x4 q[4];
#pragma unroll
            for (int i = 0; i < 4; ++i) q[i] = *(const LAS f32x4*)(QS + (4 * sb + i) * LP + 4 * d4);
            const f32x4 c0 = *(const f32x4*)(cprev + (4 * d4 + 0) * HD + 4 * eb), c1 = *(const f32x4*)(cprev + (4 * d4 + 1) * HD + 4 * eb);
            const f32x4 c2 = *(const f32x4*)(cprev + (4 * d4 + 2) * HD + 4 * eb), c3 = *(const f32x4*)(cprev + (4 * d4 + 3) * HD + 4 * eb);
#pragma unroll
            for (int i = 0; i < 4; ++i) a2[i] += q[i].x * c0 + q[i].y * c1 + q[i].z * c2 + q[i].w * c3;
        }
        const bf16* proj = (const bf16*)(F.ws + WS_PROJ);
        bf16* Y = (bf16*)(F.ws + WS_XN);
        const f32x4 gn = *(const f32x4*)(F.in[15] + hh * HD + 4 * eb);
#pragma unroll
        for (int i = 0; i < 4; ++i) {
            const int s = 4 * sb + i; const size_t m = (size_t)(b * SEQ + ch * CL + s);
            const float dn = fmaxf(fabsf(s_den[s]), __expf(-s_ms[s]));
            const f32x4 num = a1[i] + s_iw[s] * a2[i];
            const v2u ow = *(const v2u*)(proj + m * NPROJ + 2560 + hh * HD + 4 * eb);
            f32x4 o; o.x = sigmoidf_(bf2f((bf16)(ow.x & 0xffffu))); o.y = sigmoidf_(bf2f((bf16)(ow.x >> 16))); o.z = sigmoidf_(bf2f((bf16)(ow.y & 0xffffu))); o.w = sigmoidf_(bf2f((bf16)(ow.y >> 16)));
            const f32x4 hv = o * (num / dn);
            float ss = (hv.x * hv.x + hv.y * hv.y) + (hv.z * hv.z + hv.w * hv.w);
#pragma unroll
            for (int o2 = 1; o2 < 32; o2 <<= 1) ss += __shfl_xor(ss, o2);
            const float rstd = rsqrtf(ss * (1.f / HD) + EPS);
            const f32x4 y = hv * rstd * gn;
            v2u w; w.x = pk2(y.x, y.y); w.y = pk2(y.z, y.w);
            *(v2u*)(Y + m * DM + DRG + hh * HD + 4 * eb) = w;
        }
    }
    __syncthreads();
}

__device__ __forceinline__ void norm1_phase(const Frame& F) {
    const int gw = F.bid * NWAVES + F.wave, NGW = F.G * NWAVES;
    const float* mix = (const float*)(F.ws + WS_CLOC); bf16* V = (bf16*)(F.ws + WS_PROJ);
    f32x4 g1[4], g2[4];
#pragma unroll
    for (int j = 0; j < 4; ++j) { g1[j] = *(const f32x4*)(F.in[17] + 256 * j + 4 * F.lane); g2[j] = *(const f32x4*)(F.in[18] + 256 * j + 4 * F.lane); }
    for (int m = gw; m < MT; m += NGW) {
        const f32x4* mr = (const f32x4*)(mix + (size_t)m * DM) + F.lane; const f32x4* xr = (const f32x4*)(F.in[0] + (size_t)m * DM) + F.lane;
        f32x4 v[4], xv[4]; float s = 0.f;
#pragma unroll
        for (int j = 0; j < 4; ++j) { v[j] = mr[64 * j]; xv[j] = xr[64 * j]; s += (v[j].x * v[j].x + v[j].y * v[j].y) + (v[j].z * v[j].z + v[j].w * v[j].w); }
        const float rstd = rsqrtf(wave_sum(s) * (1.f / DM) + EPS);
        float s2 = 0.f;
        f32x4* orow = (f32x4*)(F.out + (size_t)m * DM) + F.lane;
#pragma unroll
        for (int j = 0; j < 4; ++j) { v[j] = xv[j] + v[j] * rstd * g1[j]; orow[64 * j] = v[j]; s2 += (v[j].x * v[j].x + v[j].y * v[j].y) + (v[j].z * v[j].z + v[j].w * v[j].w); }
        const float rstd2 = rsqrtf(wave_sum(s2) * (1.f / DM) + EPS);
        unsigned long long* o8 = (unsigned long long*)(V + (size_t)m * DM) + F.lane;
#pragma unroll
        for (int j = 0; j < 4; ++j) { const f32x4 y = v[j] * rstd2 * g2[j]; o8[64 * j] = (unsigned long long)pk2(y.x, y.y) | ((unsigned long long)pk2(y.z, y.w) << 32); }
    }
}
__device__ __forceinline__ void norm2_phase(const Frame& F) {
    const int gw = F.bid * NWAVES + F.wave, NGW = F.G * NWAVES;
    const float* ffo = (const float*)(F.ws + WS_FFO);
    f32x4 g1[4];
#pragma unroll
    for (int j = 0; j < 4; ++j) g1[j] = *(const f32x4*)(F.in[21] + 256 * j + 4 * F.lane);
    for (int m = gw; m < MT; m += NGW) {
        const f32x4* mr = (const f32x4*)(ffo + (size_t)m * DM) + F.lane; f32x4* orow = (f32x4*)(F.out + (size_t)m * DM) + F.lane;
        f32x4 v[4], xv[4]; float s = 0.f;
#pragma unroll
        for (int j = 0; j < 4; ++j) { v[j] = mr[64 * j]; xv[j] = orow[64 * j]; s += (v[j].x * v[j].x + v[j].y * v[j].y) + (v[j].z * v[j].z + v[j].w * v[j].w); }
        const float rstd = rsqrtf(wave_sum(s) * (1.f / DM) + EPS);
#pragma unroll
        for (int j = 0; j < 4; ++j) orow[64 * j] = xv[j] + v[j] * rstd * g1[j];
    }
}

struct Args { const float* in[22]; float* out; unsigned char* ws; };
__global__ void __launch_bounds__(NTHR, 2) hymba_fwd(Args args) {
    extern __shared__ __attribute__((aligned(16))) unsigned char lds[];
    cg::grid_group grid = cg::this_grid();
    Frame F;
    F.lds = (LAS unsigned char*)lds;
    F.tid = threadIdx.x; F.lane = F.tid & 63; F.wave = __builtin_amdgcn_readfirstlane(F.tid >> 6);
    F.G = gridDim.x; F.bid = blockIdx.x;
#pragma unroll
    for (int i = 0; i < 22; ++i) F.in[i] = args.in[i];
    F.out = args.out; F.ws = args.ws;
    bf16* XN = (bf16*)(F.ws + WS_XN); bf16* PROJ = (bf16*)(F.ws + WS_PROJ);

#ifndef SKIP_P0
    p0_prologue(F);
#endif
    grid.sync();
    { pg8::Gemm g{XN, (const bf16*)(F.ws + WS_WIN), MT, NPROJ, DM}; pg8::StaticOrder S; S.init(MT, NPROJ, F.G, F.bid);
      pg8::EpiBf16<0> E{PROJ, NPROJ};
      pg8::gemm_phase<pg8::EpiBf16<0>, pg8::StaticOrder, true, true>(F.lds, g, S, E); }
    grid.sync();
    if (F.bid < NB * NCH) { const int it = F.bid; const int b = it / NCH, ch = it % NCH;
#ifndef SKIP_RG
        rg_pass<false>(F, b, ch);
#endif
#pragma unroll 1
        for (int hh = 0; hh < NH; ++hh) {
#ifndef SKIP_MLA
            ml_local(F, b, ch, hh);
#endif
        } }
    grid.sync();
#ifndef SKIP_SCAN
    scan_phase(F);
#endif
    grid.sync();
    if (F.bid < NB * NCH) { const int it = F.bid; const int b = it / NCH, ch = it % NCH;
#ifndef SKIP_RG
        rg_pass<true>(F, b, ch);
#endif
#pragma unroll 1
        for (int hh = 0; hh < NH; ++hh) {
#ifndef SKIP_MLC
            ml_out(F, b, ch, hh);
#endif
        } }
    grid.sync();
    { pg8::Gemm g{XN, (const bf16*)(F.ws + WS_WO), MT, DM, DM}; pg8::StaticOrder S; S.init(MT, DM, F.G, F.bid);
      pg8::EpiF32 E{(float*)(F.ws + WS_CLOC), DM};
      pg8::gemm_phase<pg8::EpiF32, pg8::StaticOrder, true, true>(F.lds, g, S, E); }
    grid.sync();
    norm1_phase(F);
    grid.sync();
    { pg8::Gemm g{PROJ, (const bf16*)(F.ws + WS_WUP), MT, FF, DM}; pg8::StaticOrder S; S.init(MT, FF, F.G, F.bid);
      pg8::EpiBf16<2> E{(bf16*)(F.ws + WS_H), FF};
      pg8::gemm_phase<pg8::EpiBf16<2>, pg8::StaticOrder, true, true>(F.lds, g, S, E); }
    grid.sync();
    { pg8::Gemm g{(const bf16*)(F.ws + WS_H), (const bf16*)(F.ws + WS_WDN), MT, DM, FF}; pg8::StaticOrder S; S.init(MT, DM, F.G, F.bid);
      pg8::EpiF32 E{(float*)(F.ws + WS_FFO), DM};
      pg8::gemm_phase<pg8::EpiF32, pg8::StaticOrder, true, true>(F.lds, g, S, E); }
    grid.sync();
    norm2_phase(F);
}

extern "C" void kernel_launch(void* const* d_in, const int* in_sizes, int n_in, void* d_out, int out_size, void* d_ws, size_t ws_size, hipStream_t stream) {
    static int grid = 0;
    if (grid == 0) {
        int dev = 0, cus = 0, per_cu = 0;
        hipGetDevice(&dev);
        hipDeviceGetAttribute(&cus, hipDeviceAttributeMultiprocessorCount, dev);
        hipFuncSetAttribute((const void*)hymba_fwd, hipFuncAttributeMaxDynamicSharedMemorySize, LDS_BYTES);
        hipOccupancyMaxActiveBlocksPerMultiprocessor(&per_cu, (const void*)hymba_fwd, NTHR, LDS_BYTES);
        if (per_cu < 1) { fprintf(stderr, "kernel_launch: occupancy query says %d blocks per CU\n", per_cu); per_cu = 1; }
        grid = cus;
        if (n_in != 22 || out_size != MT * DM || ws_size < 256 * MiB) fprintf(stderr, "kernel_launch: unexpected shapes n_in %d out %d ws %zu\n", n_in, out_size, ws_size);
    }
    Args a{};
    for (int i = 0; i < 22; ++i) a.in[i] = (const float*)d_in[i];
    a.out = (float*)d_out; a.ws = (unsigned char*)d_ws;
    void* kargs[] = {&a};
    hipError_t e = hipLaunchCooperativeKernel((const void*)hymba_fwd, dim3(grid), dim3(NTHR), kargs, LDS_BYTES, stream);
    if (e != hipSuccess) fprintf(stderr, "cooperative launch failed: %s (grid %d)\n", hipGetErrorString(e), grid);
}
```

```cpp
#include <hip/hip_runtime.h>
#include <hip/hip_cooperative_groups.h>
#include <cstdio>
#include <cstdint>
namespace cg = cooperative_groups;
namespace pg8 {
#define PG8_LAS __attribute__((address_space(3)))
typedef unsigned short bf16_t;
typedef short bf16x8 __attribute__((ext_vector_type(8)));
typedef float f32x4 __attribute__((ext_vector_type(4)));
typedef unsigned u32x4 __attribute__((ext_vector_type(4)));
constexpr int BM = 256, BK = 64, HALF = 128, HTB = HALF * BK * 2  , STAGE_BYTES = 8 * HTB, NXCD = 8, WGM = 8;

__host__ __device__ __forceinline__ int lds_byte(int r, int c) { const int st = (r >> 4) * 2 + (c >> 5), rr = r & 15, cc = c & 31, ob = rr * 64 + cc * 2; return st * 1024 + (ob ^ (((ob >> 9) & 1) << 5)); }
__host__ __device__ __forceinline__ void stage_rc(int b, int& R, int& C) { const int st = b / 1024, sb = b % 1024, swz = sb ^ (((sb >> 9) & 1) << 5); R = (st >> 1) * 16 + swz / 64; C = (st & 1) * 32 + (swz % 64) / 2; }
__host__ __device__ __forceinline__ int perm32(int rho) { const int n = rho >> 4, i = rho & 15; return 8 * (i >> 2) + 4 * n + (i & 3); }

struct Unit { int pm, pn; };
struct Gemm { const bf16_t* A; const bf16_t* Bt; int M, N, K; };

struct StaticOrder {
    int nM, nN, nwg, G, c;
    __host__ __device__ void init(int M, int N, int G_, int c_) { nM = M / BM; nN = N / BM; nwg = nM * nN; G = G_; c = c_; }
    __host__ __device__ bool next(int i, Unit& u) const {
        const long L = (long)i * G + c; if (L >= nwg) return false;
        int wgid = (int)L; { const int q = nwg / NXCD, r = nwg % NXCD, xcd = wgid % NXCD, off = wgid / NXCD; wgid = (xcd < r ? xcd * (q + 1) : r * (q + 1) + (xcd - r) * q) + off; }
        const int nig = WGM * nN, gid = wgid / nig, fm = gid * WGM, gsz = (nM - fm) < WGM ? (nM - fm) : WGM;
        u.pm = fm + ((wgid % nig) % gsz); u.pn = (wgid % nig) / gsz; return true;
    }
    __device__ __forceinline__ void a_ready(const Unit&) const {}
    __device__ __forceinline__ void done(const Unit&) const {}
};

__device__ __forceinline__ unsigned cvt_pk_bf16(float lo, float hi) { unsigned r; asm volatile("v_cvt_pk_bf16_f32 %0, %1, %2" : "=v"(r) : "v"(lo), "v"(hi)); return r; }
template <int ACT> struct EpiBf16 {
    static constexpr bool PERM = true, AFTER_DRAIN = false;
    bf16_t* O; int ldc;
    __device__ __forceinline__ void operator()(const f32x4 (&acc)[2][2][4][2], const Unit& u, int wr, int wc, int fr, int fq) const {
        const int row0 = u.pm * BM + wr * 64 + fr; const int col0 = u.pn * BM + wc * 32 + 8 * fq;
#pragma unroll
        for (int ai = 0; ai < 2; ++ai)
#pragma unroll
            for (int m = 0; m < 4; ++m) { bf16_t* rowp = O + (size_t)(row0 + ai * HALF + m * 16) * ldc + col0;
#pragma unroll
                for (int bj = 0; bj < 2; ++bj) { f32x4 v0 = acc[ai][bj][m][0], v1 = acc[ai][bj][m][1];
                    if (ACT == 2) {
#pragma unroll
                        for (int e = 0; e < 4; ++e) { float a = fmaxf(v0[e], 0.f), b = fmaxf(v1[e], 0.f); v0[e] = a * a; v1[e] = b * b; } }
                    u32x4 w; w.x = cvt_pk_bf16(v0[0], v0[1]); w.y = cvt_pk_bf16(v0[2], v0[3]); w.z = cvt_pk_bf16(v1[0], v1[1]); w.w = cvt_pk_bf16(v1[2], v1[3]);
                    *(u32x4*)(rowp + bj * HALF) = w; } }
    }
};
struct EpiF32 {
    static constexpr bool PERM = false, AFTER_DRAIN = false;
    float* O; int ldc;
    __device__ __forceinline__ void operator()(const f32x4 (&acc)[2][2][4][2], const Unit& u, int wr, int wc, int fr, int fq) const {
        const int col0 = u.pn * BM + wc * 32 + 4 * fq;
#pragma unroll
        for (int ai = 0; ai < 2; ++ai)
#pragma unroll
            for (int m = 0; m < 4; ++m) { const int r = u.pm * BM + ai * HALF + wr * 64 + m * 16 + fr; float* rowp = O + (size_t)r * ldc + col0;
#pragma unroll
                for (int bj = 0; bj < 2; ++bj)
#pragma unroll
                    for (int n = 0; n < 2; ++n) *(f32x4*)(rowp + bj * HALF + n * 16) = acc[ai][bj][m][n]; }
    }
};
template <class Epi, class Sched, bool ALIGN_EPI = false, bool SP2 = false>
__device__ __forceinline__ void gemm_phase(PG8_LAS unsigned char* lds, const Gemm g, const Sched& S, const Epi& E) {
    const int tid = threadIdx.x, wid = __builtin_amdgcn_readfirstlane(tid >> 6), lane = tid & 63, wr = wid >> 2, wc = wid & 3, fr = lane & 15, fq = lane >> 4;
    const int K = g.K, nt = K / BK;
    unsigned voffA[2], voffB[2];
#pragma unroll
    for (int i = 0; i < 2; ++i) { int R, C; stage_rc(tid * 16 + i * 8192, R, C); const int Rb = Epi::PERM ? ((R & ~31) + perm32(R & 31)) : R;
        voffA[i] = (unsigned)(R * K + C) * 2u; voffB[i] = (unsigned)(Rb * K + C) * 2u; }
    const size_t kstep = (size_t)(BK * 2);
    const size_t hstep = (size_t)HALF * K * 2;
    const size_t tstep = 2 * hstep;
    const unsigned ldsw = (unsigned)wid * 1024u;
    const int aoff = lds_byte(wr * 64 + fr, fq * 8), boff = lds_byte(wc * 32 + fr, fq * 8);
#define PG8_SA(b, h) (((b) * 2 + (h)) * HTB)
#define PG8_SB(b, h) ((4 + (b) * 2 + (h)) * HTB)
#define PG8_STAGE(bufoff, gbase, voff) do { _Pragma("unroll") for (int _i = 0; _i < 2; ++_i) \
        __builtin_amdgcn_global_load_lds((const unsigned*)((const char*)(gbase) + (voff)[_i]), (PG8_LAS unsigned*)(lds + (bufoff) + ldsw + _i * 8192), 16, 0, 0); } while (0)
#define PG8_LDA(dst, b, h) do { _Pragma("unroll") for (int m = 0; m < 4; ++m) _Pragma("unroll") for (int k = 0; k < 2; ++k) dst[m][k] = *(const PG8_LAS bf16x8*)(lds + PG8_SA(b, h) + aoff + m * 2048 + k * 1024); } while (0)
#define PG8_LDB(dst, b, h) do { _Pragma("unroll") for (int n = 0; n < 2; ++n) _Pragma("unroll") for (int k = 0; k < 2; ++k) dst[n][k] = *(const PG8_LAS bf16x8*)(lds + PG8_SB(b, h) + boff + n * 2048 + k * 1024); } while (0)
#define PG8_MMA(ai, bj, At, Bt) do { __builtin_amdgcn_s_setprio(1); _Pragma("unroll") for (int m = 0; m < 4; ++m) _Pragma("unroll") for (int n = 0; n < 2; ++n) _Pragma("unroll") for (int k = 0; k < 2; ++k) \
        acc[ai][bj][m][n] = __builtin_amdgcn_mfma_f32_16x16x32_bf16(Bt[n][k], At[m][k], acc[ai][bj][m][n], 0, 0, 0); __builtin_amdgcn_s_setprio(0); } while (0)
#define PG8_WAIT_V(n) asm volatile("s_waitcnt vmcnt(" #n ")" ::: "memory")
#define PG8_WAIT_L(n) asm volatile("s_waitcnt lgkmcnt(" #n ")" ::: "memory")
#define PG8_BAR __builtin_amdgcn_s_barrier()
#define PG8_SCHED __builtin_amdgcn_sched_barrier(0)
    Unit cur, nxt; int ui = 0;
    if (!S.next(0, cur)) return;
    f32x4 acc[2][2][4][2];
#pragma unroll
    for (int a = 0; a < 2; ++a)
#pragma unroll
        for (int b = 0; b < 2; ++b)
#pragma unroll
            for (int m = 0; m < 4; ++m)
#pragma unroll
                for (int n = 0; n < 2; ++n) acc[a][b][m][n] = (f32x4){0.f, 0.f, 0.f, 0.f};
    bf16x8 At[4][2], B0[2][2], B1[2][2];
    const char* cA = (const char*)g.A + (size_t)cur.pm * tstep; const char* cB = (const char*)g.Bt + (size_t)cur.pn * tstep;
    S.a_ready(cur);
    if constexpr (SP2) {
        PG8_STAGE(PG8_SB(0, 0), cB, voffB); PG8_STAGE(PG8_SB(0, 1), cB + hstep, voffB); PG8_STAGE(PG8_SA(0, 0), cA, voffA); PG8_STAGE(PG8_SA(0, 1), cA + hstep, voffA);
        if (wr == 1) PG8_BAR;
        PG8_WAIT_V(2); PG8_BAR;
        PG8_STAGE(PG8_SB(1, 0), cB + kstep, voffB); PG8_STAGE(PG8_SA(1, 0), cA + kstep, voffA); PG8_STAGE(PG8_SB(1, 1), cB + hstep + kstep, voffB);
        PG8_WAIT_V(6); PG8_BAR;
    } else {
        PG8_STAGE(PG8_SB(0, 0), cB, voffB); PG8_STAGE(PG8_SA(0, 0), cA, voffA); PG8_STAGE(PG8_SB(0, 1), cB + hstep, voffB); PG8_STAGE(PG8_SA(0, 1), cA + hstep, voffA);
        if (wr == 1) PG8_BAR;
        PG8_WAIT_V(4); PG8_BAR;
        PG8_STAGE(PG8_SB(1, 0), cB + kstep, voffB); PG8_STAGE(PG8_SA(1, 0), cA + kstep, voffA); PG8_STAGE(PG8_SB(1, 1), cB + hstep + kstep, voffB);
        PG8_WAIT_V(6); PG8_BAR;
    }
    for (;;) {
        const bool has_next = S.next(ui + 1, nxt);
        const char* nA = has_next ? (const char*)g.A + (size_t)nxt.pm * tstep : cA; const char* nB = has_next ? (const char*)g.Bt + (size_t)nxt.pn * tstep : cB;
        for (int t = 0; t < nt; t += 2) {
            const bool last = (t == nt - 2);
            const char* a1 = cA + (size_t)(t + 1) * kstep;
            const char* a2 = last ? nA : cA + (size_t)(t + 2) * kstep; const char* b2 = last ? nB : cB + (size_t)(t + 2) * kstep;
            const char* a3 = a2 + kstep; const char* b3 = b2 + kstep;
            if (last && has_next) S.a_ready(nxt);
            if constexpr (SP2) {
            PG8_LDB(B0, 0, 0); PG8_LDB(B1, 0, 1); PG8_SCHED; PG8_LDA(At, 0, 0); PG8_STAGE(PG8_SA(1, 1), a1 + hstep, voffA);
            PG8_WAIT_V(8); PG8_WAIT_L(0); PG8_BAR; PG8_MMA(0, 0, At, B0); PG8_MMA(0, 1, At, B1); PG8_BAR; PG8_SCHED;
            PG8_LDA(At, 0, 1); PG8_STAGE(PG8_SB(0, 0), b2, voffB); PG8_STAGE(PG8_SB(0, 1), b2 + hstep, voffB); PG8_STAGE(PG8_SA(0, 0), a2, voffA);
            PG8_WAIT_V(8); PG8_WAIT_L(0); PG8_BAR; PG8_MMA(1, 0, At, B0); PG8_MMA(1, 1, At, B1); PG8_BAR; PG8_SCHED;
            PG8_LDB(B0, 1, 0); PG8_LDB(B1, 1, 1); PG8_SCHED; PG8_LDA(At, 1, 0); PG8_STAGE(PG8_SA(0, 1), a2 + hstep, voffA);
            PG8_WAIT_V(8); PG8_WAIT_L(0); PG8_BAR; PG8_MMA(0, 0, At, B0); PG8_MMA(0, 1, At, B1); PG8_BAR; PG8_SCHED;
            PG8_LDA(At, 1, 1); PG8_STAGE(PG8_SB(1, 0), b3, voffB); PG8_STAGE(PG8_SB(1, 1), b3 + hstep, voffB); PG8_STAGE(PG8_SA(1, 0), a3, voffA);
            PG8_WAIT_V(8); PG8_WAIT_L(0); PG8_BAR; PG8_MMA(1, 0, At, B0); PG8_MMA(1, 1, At, B1); PG8_BAR; PG8_SCHED;
            } else {
            PG8_LDB(B0, 0, 0); PG8_SCHED; PG8_LDA(At, 0, 0); PG8_STAGE(PG8_SA(1, 1), a1 + hstep, voffA);
            PG8_WAIT_L(8); PG8_BAR; PG8_WAIT_L(0); PG8_MMA(0, 0, At, B0); PG8_BAR; PG8_SCHED;
            PG8_LDB(B1, 0, 1); PG8_STAGE(PG8_SB(0, 0), b2, voffB);
            PG8_BAR; PG8_WAIT_L(0); PG8_MMA(0, 1, At, B1); PG8_BAR;
            PG8_LDA(At, 0, 1); PG8_STAGE(PG8_SA(0, 0), a2, voffA);
            PG8_BAR; PG8_WAIT_L(0); PG8_MMA(1, 0, At, B0); PG8_BAR; PG8_SCHED;
            PG8_STAGE(PG8_SB(0, 1), b2 + hstep, voffB);
            PG8_WAIT_V(6); PG8_BAR; PG8_MMA(1, 1, At, B1); PG8_BAR;
            PG8_LDB(B0, 1, 0); PG8_SCHED; PG8_LDA(At, 1, 0); PG8_STAGE(PG8_SA(0, 1), a2 + hstep, voffA);
            PG8_WAIT_L(8); PG8_BAR; PG8_WAIT_L(0); PG8_MMA(0, 0, At, B0); PG8_BAR; PG8_SCHED;
            PG8_LDB(B1, 1, 1); PG8_STAGE(PG8_SB(1, 0), b3, voffB);
            PG8_BAR; PG8_WAIT_L(0); PG8_MMA(0, 1, At, B1); PG8_BAR;
            PG8_LDA(At, 1, 1); PG8_STAGE(PG8_SA(1, 0), a3, voffA);
            PG8_BAR; PG8_WAIT_L(0); PG8_MMA(1, 0, At, B0); PG8_BAR; PG8_SCHED;
            PG8_STAGE(PG8_SB(1, 1), b3 + hstep, voffB);
            PG8_WAIT_V(6); PG8_BAR; PG8_MMA(1, 1, At, B1); PG8_BAR;
            }
        }
        if constexpr (ALIGN_EPI) { if (wr == 0) PG8_BAR; }
        if constexpr (!Epi::AFTER_DRAIN) { E(acc, cur, wr, wc, fr, fq); S.done(cur); }
        if (!has_next) break;
#pragma unroll
        for (int a = 0; a < 2; ++a)
#pragma unroll
            for (int b = 0; b < 2; ++b)
#pragma unroll
                for (int m = 0; m < 4; ++m)
#pragma unroll
                    for (int n = 0; n < 2; ++n) acc[a][b][m][n] = (f32x4){0.f, 0.f, 0.f, 0.f};
        cur = nxt; cA = nA; cB = nB; ++ui;
        if constexpr (ALIGN_EPI) { if (wr == 1) PG8_BAR; }
    }
    PG8_WAIT_V(0);
    if constexpr (!ALIGN_EPI) { if (wr == 0) PG8_BAR; }
    PG8_BAR;
    if constexpr (Epi::AFTER_DRAIN) { E.fused(acc, cur, wr, wc, fr, fq, lds, wid, lane); S.done(cur); }
#undef PG8_SA
#undef PG8_SB
#undef PG8_STAGE
#undef PG8_LDA
#undef PG8_LDB
#undef PG8_MMA
#undef PG8_WAIT_V
#undef PG8_WAIT_L
#undef PG8_BAR
#undef PG8_SCHED
}
}

constexpr int NB = 8, SEQ = 2048, DM = 1024, MT = NB * SEQ, DIN = 3080, NPROJ = 3072, FF = 4096;
constexpr int NCH = 32, CL = 64, NH = 4, HD = 128, DRG = 512;
constexpr float EPS = 1e-6f;
constexpr int NWAVES = 8, NTHR = 512;
constexpr size_t MiB = 1u << 20;
constexpr size_t WS_WIN = 1 * MiB, WS_WO = 7 * MiB, WS_WUP = 9 * MiB, WS_WDN = 17 * MiB;
constexpr size_t WS_GATES = 25 * MiB;
constexpr size_t WS_RGA = 26 * MiB, WS_RGH = 26 * MiB + 512 * 1024, WS_RGIN = 27 * MiB;
constexpr size_t WS_MLOC = 28 * MiB, WS_BLAST = 28 * MiB + 65536, WS_MPREV = 28 * MiB + 131072;
constexpr size_t WS_XN = 32 * MiB;
constexpr size_t WS_PROJ = 64 * MiB;
constexpr size_t WS_CLOC = 160 * MiB;
constexpr size_t WS_H = 96 * MiB;
constexpr size_t WS_FFO = 32 * MiB;
constexpr int CITEM = 129 * 128;
constexpr int LDS_BYTES = 147456;

#define LAS __attribute__((address_space(3)))
typedef unsigned short bf16;
typedef unsigned v4u __attribute__((ext_vector_type(4)));
typedef unsigned v2u __attribute__((ext_vector_type(2)));
typedef float f32x4 __attribute__((ext_vector_type(4)));
#define LDS_WAIT() asm volatile("s_waitcnt lgkmcnt(0)" ::: "memory")
__device__ __forceinline__ unsigned f2bf(float f) { unsigned u = __builtin_bit_cast(unsigned, f); return (u + 0x7fffu + ((u >> 16) & 1u)) >> 16; }
__device__ __forceinline__ unsigned pk2(float lo, float hi) { return f2bf(lo) | (f2bf(hi) << 16); }
__device__ __forceinline__ float bf2f(bf16 u) { return __builtin_bit_cast(float, (unsigned)u << 16); }
__device__ __forceinline__ float wave_sum(float v) {
#pragma unroll
    for (int o = 1; o < 64; o <<= 1) v += __shfl_xor(v, o);
    return v;
}
__device__ __forceinline__ float wave_max(float v) {
#pragma unroll
    for (int o = 1; o < 64; o <<= 1) v = fmaxf(v, __shfl_xor(v, o));
    return v;
}
__device__ __forceinline__ float sigmoidf_(float z) { return 1.f / (1.f + __expf(-z)); }
__device__ __forceinline__ float logsigmoidf_(float z) { return fminf(z, 0.f) - log1pf(__expf(-fabsf(z))); }
__device__ __forceinline__ float gelu_tanh(float v) { const float u = 0.7978845608028654f * (v + 0.044715f * v * v * v); return 0.5f * v * (1.f + tanhf(u)); }
__device__ __forceinline__ float rdlane(float v, int l) { return __builtin_bit_cast(float, __builtin_amdgcn_readlane(__builtin_bit_cast(int, v), l)); }

struct Frame {
    LAS unsigned char* lds;
    int tid, lane, wave, G, bid;
    const float* in[22]; float* out; unsigned char* ws;
};

__device__ __forceinline__ void p0_transpose_item(const float* W, int K, int ldw, int nblk, bf16* WT, LAS float* scr, int item, int lane) {
    const int kb = item / nblk, nb = item % nblk, k0 = 64 * kb, n0 = 32 * nb;
#pragma unroll 8
    for (int i = 0; i < 32; ++i) { const int kk = 2 * i + (lane >> 5); scr[kk * 33 + (lane & 31)] = W[(size_t)(k0 + kk) * ldw + n0 + (lane & 31)]; }
    LDS_WAIT(); asm volatile("" ::: "memory");
    const int c = lane & 7;
#pragma unroll
    for (int j = 0; j < 4; ++j) { const int n = (lane >> 3) + 8 * j; const LAS float* s = scr + (8 * c) * 33 + n;
        v4u o; o.x = pk2(s[0 * 33], s[1 * 33]); o.y = pk2(s[2 * 33], s[3 * 33]); o.z = pk2(s[4 * 33], s[5 * 33]); o.w = pk2(s[6 * 33], s[7 * 33]);
        *(v4u*)(WT + (size_t)(n0 + n) * K + k0 + 8 * c) = o; }
    LDS_WAIT(); asm volatile("" ::: "memory");
}

__device__ __forceinline__ void p0_prologue(const Frame& F) {
    LAS float* scr = (LAS float*)(F.lds + F.wave * 16384);
    const int gw = F.bid * NWAVES + F.wave, NGW = F.G * NWAVES;
    constexpr int I_IN = (DM / 64) * (NPROJ / 32), I_O = (DM / 64) * (DM / 32), I_UP = (DM / 64) * (FF / 32), I_DN = (FF / 64) * (DM / 32);
    constexpr int NITEMS = I_IN + I_O + I_UP + I_DN;
    bf16* win_t = (bf16*)(F.ws + WS_WIN); bf16* wo_t = (bf16*)(F.ws + WS_WO); bf16* wup_t = (bf16*)(F.ws + WS_WUP); bf16* wdn_t = (bf16*)(F.ws + WS_WDN);
    for (int it = gw; it < NITEMS; it += NGW) {
        int r = it;
        if (r < I_IN) { p0_transpose_item(F.in[2], DM, DIN, NPROJ / 32, win_t, scr, r, F.lane); continue; } r -= I_IN;
        if (r < I_O) { p0_transpose_item(F.in[16], DM, DM, DM / 32, wo_t, scr, r, F.lane); continue; } r -= I_O;
        if (r < I_UP) { p0_transpose_item(F.in[19], DM, FF, FF / 32, wup_t, scr, r, F.lane); continue; } r -= I_UP;
        p0_transpose_item(F.in[20], FF, DM, DM / 32, wdn_t, scr, r, F.lane);
    }
    __syncthreads();
    LAS float* wg = (LAS float*)F.lds;
    for (int e = F.tid; e < 8 * DM; e += NTHR) { const int k = e >> 3, n = e & 7; wg[n * DM + k] = F.in[2][(size_t)k * DIN + NPROJ + n]; }
    __syncthreads();
    const float* x = F.in[0]; bf16* xn = (bf16*)(F.ws + WS_XN); float* gates = (float*)(F.ws + WS_GATES);
    f32x4 gn[4];
#pragma unroll
    for (int j = 0; j < 4; ++j) gn[j] = *(const f32x4*)(F.in[1] + 256 * j + 4 * F.lane);
    for (int m = gw; m < MT; m += NGW) {
        const f32x4* xr = (const f32x4*)(x + (size_t)m * DM) + F.lane;
        f32x4 v[4]; float s = 0.f;
#pragma unroll
        for (int j = 0; j < 4; ++j) { v[j] = xr[64 * j]; s += (v[j].x * v[j].x + v[j].y * v[j].y) + (v[j].z * v[j].z + v[j].w * v[j].w); }
        const float rstd = rsqrtf(wave_sum(s) * (1.f / DM) + EPS);
        unsigned long long* o8 = (unsigned long long*)(xn + (size_t)m * DM) + F.lane;
        float ga[8];
#pragma unroll
        for (int n = 0; n < 8; ++n) ga[n] = 0.f;
#pragma unroll
        for (int j = 0; j < 4; ++j) {
            v[j] = v[j] * rstd * gn[j];
            o8[64 * j] = (unsigned long long)pk2(v[j].x, v[j].y) | ((unsigned long long)pk2(v[j].z, v[j].w) << 32);
#pragma unroll
            for (int n = 0; n < 8; ++n) { const f32x4 w = *(const LAS f32x4*)(wg + n * DM + 256 * j + 4 * F.lane);
                ga[n] += (v[j].x * w.x + v[j].y * w.y) + (v[j].z * w.z + v[j].w * w.w); }
        }
#pragma unroll
        for (int n = 0; n < 8; ++n) ga[n] = wave_sum(ga[n]);
        if (F.lane == 0) { *(f32x4*)(gates + (size_t)m * 8) = (f32x4){ga[0], ga[1], ga[2], ga[3]}; *(f32x4*)(gates + (size_t)m * 8 + 4) = (f32x4){ga[4], ga[5], ga[6], ga[7]}; }
    }
    __syncthreads();
}

typedef short bf16x8 __attribute__((ext_vector_type(8)));
#define MFMA16(a, b, c) __builtin_amdgcn_mfma_f32_16x16x32_bf16(a, b, c, 0, 0, 0)
__device__ __forceinline__ bf16x8 pack8(f32x4 lo, f32x4 hi) { v4u o; o.x = pk2(lo.x, lo.y); o.y = pk2(lo.z, lo.w); o.z = pk2(hi.x, hi.y); o.w = pk2(hi.z, hi.w); return __builtin_bit_cast(bf16x8, o); }
__device__ __forceinline__ f32x4 unpk_lo(v4u r) { return (f32x4){__builtin_bit_cast(float, r.x << 16), __builtin_bit_cast(float, r.x & 0xffff0000u), __builtin_bit_cast(float, r.y << 16), __builtin_bit_cast(float, r.y & 0xffff0000u)}; }
__device__ __forceinline__ f32x4 unpk_hi(v4u r) { return (f32x4){__builtin_bit_cast(float, r.z << 16), __builtin_bit_cast(float, r.z & 0xffff0000u), __builtin_bit_cast(float, r.w << 16), __builtin_bit_cast(float, r.w & 0xffff0000u)}; }
__device__ __forceinline__ f32x4 unpk2(v2u r) { return (f32x4){__builtin_bit_cast(float, r.x << 16), __builtin_bit_cast(float, r.x & 0xffff0000u), __builtin_bit_cast(float, r.y << 16), __builtin_bit_cast(float, r.y & 0xffff0000u)}; }

constexpr int VP = 516;

template <bool FINAL>
__device__ __forceinline__ void rg_pass(const Frame& F, int b, int ch) {
    const int l = F.lane, q = l >> 4, r16 = l & 15, g = F.wave;
    const bf16* proj = (const bf16*)(F.ws + WS_PROJ);
    const size_t row0 = (size_t)(b * SEQ + ch * CL);
    LAS float* val = (LAS float*)F.lds;
    bf16x8 xa[4][2];
#pragma unroll
    for (int kk = 0; kk < 2; ++kk) {
        const int c8 = 64 * g + 32 * kk + 8 * q;
        f32x4 cw[4][2];
#pragma unroll
        for (int tap = 0; tap < 4; ++tap) { cw[tap][0] = *(const f32x4*)(F.in[3] + tap * DRG + c8); cw[tap][1] = *(const f32x4*)(F.in[3] + tap * DRG + c8 + 4); }
        const f32x4 cb0 = *(const f32x4*)(F.in[4] + c8), cb1 = *(const f32x4*)(F.in[4] + c8 + 4);
#pragma unroll
        for (int m = 0; m < 4; ++m) {
            const int t = 16 * m + r16;
            const bf16* p = proj + (row0 + t) * NPROJ + c8;
            f32x4 lo = cb0, hi = cb1;
#pragma unroll
            for (int tap = 0; tap < 4; ++tap) {
                const int dt = tap - 3;
                const bool ok = (ch > 0) || (t + dt >= 0);
                const bf16* pp = ok ? (p + (ptrdiff_t)dt * NPROJ) : p;
                v4u raw = *(const v4u*)pp;
                if (!ok) raw = (v4u){0u, 0u, 0u, 0u};
                lo += cw[tap][0] * unpk_lo(raw); hi += cw[tap][1] * unpk_hi(raw);
            }
            xa[m][kk] = pack8(lo, hi);
        }
    }
    const float* pwr = F.in[5]; const float* pwi = F.in[7];
#pragma unroll 1
    for (int j = 0; j < 4; ++j) {
        const int cj = 64 * g + 16 * j + r16;
        bf16 gt[4][4];
        if (FINAL) {
#pragma unroll
            for (int m = 0; m < 4; ++m)
#pragma unroll
                for (int i = 0; i < 4; ++i) gt[m][i] = proj[(row0 + 16 * m + 4 * q + i) * NPROJ + DRG + cj];
        }
        bf16x8 wrf[2], wif[2];
#pragma unroll
        for (int kk = 0; kk < 2; ++kk) {
            const float* pr = pwr + (size_t)((g * 64 + 32 * kk + 8 * q) * 64 + 16 * j + r16);
            const float* pi = pwi + (size_t)((g * 64 + 32 * kk + 8 * q) * 64 + 16 * j + r16);
            wrf[kk] = pack8((f32x4){pr[0], pr[64], pr[128], pr[192]}, (f32x4){pr[256], pr[320], pr[384], pr[448]});
            wif[kk] = pack8((f32x4){pi[0], pi[64], pi[128], pi[192]}, (f32x4){pi[256], pi[320], pi[384], pi[448]});
        }
        const int e1 = r16 - 8 * (q - 2 * (j & 1));
        v4u idv;
        idv.x = (e1 == 0 ? 0x3F80u : 0u) | (e1 == 1 ? 0x3F800000u : 0u); idv.y = (e1 == 2 ? 0x3F80u : 0u) | (e1 == 3 ? 0x3F800000u : 0u);
        idv.z = (e1 == 4 ? 0x3F80u : 0u) | (e1 == 5 ? 0x3F800000u : 0u); idv.w = (e1 == 6 ? 0x3F80u : 0u) | (e1 == 7 ? 0x3F800000u : 0u);
        const bf16x8 idf = __builtin_bit_cast(bf16x8, idv);
        const float br = F.in[6][cj], bi = F.in[8][cj];
        const float zl = -F.in[9][cj];
        const float sp8 = 8.f * (fmaxf(zl, 0.f) + log1pf(__expf(-fabsf(zl))));
        float hrun = 0.f, Aall = 1.f;
        if (FINAL) hrun = ((const float*)(F.ws + WS_RGIN))[(b * NCH + ch) * DRG + cj];
#pragma unroll
        for (int m = 0; m < 4; ++m) {
            f32x4 ar = (f32x4){0.f, 0.f, 0.f, 0.f}, ai = ar, ax = ar;
            ar = MFMA16(xa[m][0], wrf[0], ar); ar = MFMA16(xa[m][1], wrf[1], ar);
            ai = MFMA16(xa[m][0], wif[0], ai); ai = MFMA16(xa[m][1], wif[1], ai);
            const bf16x8 xid = (j & 2) ? xa[m][1] : xa[m][0];
            ax = MFMA16(xid, idf, ax);
            float a[4], bb[4];
#pragma unroll
            for (int i = 0; i < 4; ++i) {
                const float r = sigmoidf_(ar[i] + br), ig = sigmoidf_(ai[i] + bi);
                const float la = -sp8 * r;
                a[i] = __expf(la);
                bb[i] = sqrtf(-expm1f(2.f * la)) * (ig * ax[i]);
            }
            const float Am = (a[0] * a[1]) * (a[2] * a[3]);
            const float Bm = ((bb[0] * a[1] + bb[1]) * a[2] + bb[2]) * a[3] + bb[3];
            float hstart = 0.f;
#pragma unroll
            for (int q2 = 0; q2 < 4; ++q2) {
                const float Aq = __shfl(Am, r16 + 16 * q2), Bq = __shfl(Bm, r16 + 16 * q2);
                if (q == q2) hstart = hrun;
                hrun = Aq * hrun + Bq;
                if (!FINAL) Aall *= Aq;
            }
            if (FINAL) {
                float h = hstart;
#pragma unroll
                for (int i = 0; i < 4; ++i) { h = a[i] * h + bb[i]; val[(16 * m + 4 * q + i) * VP + cj] = h * gelu_tanh(bf2f(gt[m][i])); }
            }
        }
        if (!FINAL && q == 0) {
            ((float*)(F.ws + WS_RGA))[(b * NCH + ch) * DRG + cj] = Aall;
            ((float*)(F.ws + WS_RGH))[(b * NCH + ch) * DRG + cj] = hrun;
        }
    }
    if (FINAL) {
        __syncthreads();
        bf16* Y = (bf16*)(F.ws + WS_XN);
        const f32x4 g0 = *(const f32x4*)(F.in[14] + 8 * F.lane), g1 = *(const f32x4*)(F.in[14] + 8 * F.lane + 4);
#pragma unroll 2
        for (int tt = 0; tt < 8; ++tt) {
            const int t = F.wave * 8 + tt;
            const f32x4 a0 = *(const LAS f32x4*)(val + t * VP + 8 * F.lane), a1 = *(const LAS f32x4*)(val + t * VP + 8 * F.lane + 4);
            float s = (a0.x * a0.x + a0.y * a0.y) + (a0.z * a0.z + a0.w * a0.w) + (a1.x * a1.x + a1.y * a1.y) + (a1.z * a1.z + a1.w * a1.w);
            const float rstd = rsqrtf(wave_sum(s) * (1.f / DRG) + EPS);
            const f32x4 y0 = a0 * rstd * g0, y1 = a1 * rstd * g1;
            v4u o; o.x = pk2(y0.x, y0.y); o.y = pk2(y0.z, y0.w); o.z = pk2(y1.x, y1.y); o.w = pk2(y1.z, y1.w);
            *(v4u*)(Y + (row0 + t) * DM + 8 * F.lane) = o;
        }
        __syncthreads();
    }
}

constexpr int TP = 72;
constexpr int NP = 136;
constexpr int T_NAT = 64 * NP, T_TR = 128 * TP;
constexpr int SLOT_A = 2 * T_TR;
constexpr int SLOT_C = 2 * T_NAT + T_TR;
constexpr int SM_OFF_BYTES = 2 * SLOT_C * 2;
static_assert(SM_OFF_BYTES + 4096 <= 131072 && 2 * SLOT_A * 2 <= SM_OFF_BYTES, "lds");

template <bool CONV, bool KW, bool TR>
__device__ __forceinline__ void ml_stage(const Frame& F, int b, int ch, int col0, int cc0, float scl, const LAS float* kw, LAS bf16* dst) {
    const int d = F.tid & 127, tq = F.tid >> 7;
    const bf16* proj = (const bf16*)(F.ws + WS_PROJ);
    const bf16* p = proj + (size_t)(b * SEQ + ch * CL + 16 * tq) * NPROJ + col0 + d;
    bf16 raw[19];
    const bool has_halo = (ch > 0) || (tq > 0);
#pragma unroll
    for (int u = 0; u < 16; ++u) raw[3 + u] = p[(size_t)u * NPROJ];
    float v[16];
    if (CONV) {
#pragma unroll
        for (int u = 0; u < 3; ++u) raw[u] = has_halo ? *(p - (ptrdiff_t)(3 - u) * NPROJ) : (bf16)0;
        const float w0 = F.in[10][cc0 + d], w1 = F.in[10][DM + cc0 + d], w2 = F.in[10][2 * DM + cc0 + d], w3 = F.in[10][3 * DM + cc0 + d], bb = F.in[11][cc0 + d];
#pragma unroll
        for (int u = 0; u < 16; ++u) {
            float x = bb + w0 * bf2f(raw[u]) + w1 * bf2f(raw[u + 1]) + w2 * bf2f(raw[u + 2]) + w3 * bf2f(raw[u + 3]);
            x = x * sigmoidf_(x) * scl;
            if (KW) x *= kw[16 * tq + u];
            v[u] = x;
        }
    } else {
#pragma unroll
        for (int u = 0; u < 16; ++u) v[u] = bf2f(raw[3 + u]);
    }
    if (TR) {
        v4u o0, o1;
        o0.x = pk2(v[0], v[1]); o0.y = pk2(v[2], v[3]); o0.z = pk2(v[4], v[5]); o0.w = pk2(v[6], v[7]);
        o1.x = pk2(v[8], v[9]); o1.y = pk2(v[10], v[11]); o1.z = pk2(v[12], v[13]); o1.w = pk2(v[14], v[15]);
        *(LAS v4u*)(dst + d * TP + 16 * tq) = o0; *(LAS v4u*)(dst + d * TP + 16 * tq + 8) = o1;
    } else {
#pragma unroll
        for (int u = 0; u < 16; ++u) dst[(16 * tq + u) * NP + d] = (bf16)f2bf(v[u]);
    }
}

__device__ __forceinline__ void ml_local(const Frame& F, int b, int ch, int r) {
    LAS bf16* T = (LAS bf16*)F.lds;
    LAS float* kw = (LAS float*)(F.lds + SM_OFF_BYTES);
    const float* gates = (const float*)(F.ws + WS_GATES);
    const int l = F.lane, q = l >> 4, r16 = l & 15;
    if (F.wave < 2) {
        const int hh = 2 * r + F.wave, item = (b * NH + hh) * NCH + ch;
        const int m = b * SEQ + ch * CL + l;
        const float li = gates[(size_t)m * 8 + hh] + F.in[12][hh];
        const float lf = logsigmoidf_(gates[(size_t)m * 8 + 4 + hh] + F.in[13][hh]);
        float bc = lf;
#pragma unroll
        for (int o = 1; o < 64; o <<= 1) { const float t = __shfl_up(bc, o); if (l >= o) bc += t; }
        const float blast = __shfl(bc, 63);
        const float w = blast - bc + li;
        const float mloc = wave_max(w);
        kw[F.wave * 64 + l] = __expf(w - mloc);
        if (l == 0) { ((float*)(F.ws + WS_MLOC))[item] = mloc; ((float*)(F.ws + WS_BLAST))[item] = blast; }
    }
    __syncthreads();
#pragma unroll
    for (int hl = 0; hl < 2; ++hl) { const int hh = 2 * r + hl;
        ml_stage<true, true, true>(F, b, ch, 1536 + hh * HD, 512 + hh * HD, 1.f, kw + hl * 64, T + hl * SLOT_A);
        ml_stage<false, false, true>(F, b, ch, 2048 + hh * HD, 0, 1.f, kw, T + hl * SLOT_A + T_TR); }
    __syncthreads();
    {
        const int hl = F.wave >> 2, part = F.wave & 3, hh = 2 * r + hl, item = (b * NH + hh) * NCH + ch;
        const LAS bf16* KT = T + hl * SLOT_A; const LAS bf16* VT = KT + T_TR;
        f32x4 acc[2][8];
#pragma unroll
        for (int mi = 0; mi < 2; ++mi)
#pragma unroll
            for (int n = 0; n < 8; ++n) acc[mi][n] = (f32x4){0.f, 0.f, 0.f, 0.f};
#pragma unroll
        for (int kk = 0; kk < 2; ++kk) {
            bf16x8 af[2];
#pragma unroll
            for (int mi = 0; mi < 2; ++mi) af[mi] = *(const LAS bf16x8*)(KT + (16 * (2 * part + mi) + r16) * TP + 32 * kk + 8 * q);
#pragma unroll
            for (int n = 0; n < 8; ++n) {
                const bf16x8 bv = *(const LAS bf16x8*)(VT + (16 * n + r16) * TP + 32 * kk + 8 * q);
#pragma unroll
                for (int mi = 0; mi < 2; ++mi) acc[mi][n] = MFMA16(af[mi], bv, acc[mi][n]);
            }
        }
        float* base = (float*)(F.ws + WS_CLOC) + (size_t)item * CITEM;
#pragma unroll
        for (int mi = 0; mi < 2; ++mi)
#pragma unroll
            for (int n = 0; n < 8; ++n) *(f32x4*)(base + (16 * n + r16) * HD + 16 * (2 * part + mi) + 4 * q) = acc[mi][n];
    }
    if (F.tid < 256) {
        const int hl = F.tid >> 7, d = F.tid & 127, hh = 2 * r + hl, item = (b * NH + hh) * NCH + ch;
        const LAS bf16* KT = T + hl * SLOT_A;
        float s = 0.f;
#pragma unroll
        for (int k8 = 0; k8 < 8; ++k8) { const v4u w = *(const LAS v4u*)(KT + d * TP + 8 * k8); const f32x4 a = unpk_lo(w), c = unpk_hi(w); s += (a.x + a.y) + (a.z + a.w) + (c.x + c.y) + (c.z + c.w); }
        ((float*)(F.ws + WS_CLOC))[(size_t)item * CITEM + HD * HD + d] = s;
    }
    __syncthreads();
}

__device__ __forceinline__ void ml_out(const Frame& F, int b, int ch, int r) {
    LAS bf16* T = (LAS bf16*)F.lds;
    LAS float* small = (LAS float*)(F.lds + SM_OFF_BYTES);
    const float* gates = (const float*)(F.ws + WS_GATES);
    const int l = F.lane, q = l >> 4, r16 = l & 15;
    const size_t row0 = (size_t)(b * SEQ + ch * CL);
    if (F.wave < 2) {
        const int hh = 2 * r + F.wave, item = (b * NH + hh) * NCH + ch;
        const float mprev = ((const float*)(F.ws + WS_MPREV))[item];
        const int m = b * SEQ + ch * CL + l;
        const float li = gates[(size_t)m * 8 + hh] + F.in[12][hh];
        const float lf = logsigmoidf_(gates[(size_t)m * 8 + 4 + hh] + F.in[13][hh]);
        float bc = lf;
#pragma unroll
        for (int o = 1; o < 64; o <<= 1) { const float t = __shfl_up(bc, o); if (l >= o) bc += t; }
        float gm = li - bc;
        const float gj = gm;
#pragma unroll
        for (int o = 1; o < 64; o <<= 1) { const float t = __shfl_up(gm, o); if (l >= o) gm = fmaxf(gm, t); }
        const float ms = bc + fmaxf(mprev, gm);
        LAS float* sm = small + F.wave * 256;
        sm[l] = gj; sm[64 + l] = bc - ms; sm[128 + l] = __expf(bc + mprev - ms); sm[192 + l] = __expf(-ms);
    }
#pragma unroll
    for (int hl = 0; hl < 2; ++hl) { const int hh = 2 * r + hl;
        ml_stage<true, false, false>(F, b, ch, 1024 + hh * HD, hh * HD, 0.08838834764831845f, small, T + hl * SLOT_C);
        ml_stage<true, false, false>(F, b, ch, 1536 + hh * HD, 512 + hh * HD, 1.f, small, T + hl * SLOT_C + T_NAT);
        ml_stage<false, false, true>(F, b, ch, 2048 + hh * HD, 0, 1.f, small, T + hl * SLOT_C + 2 * T_NAT); }
    __syncthreads();
    {
        const int hl = F.wave >> 2, sb = F.wave & 3, hh = 2 * r + hl, item = (b * NH + hh) * NCH + ch;
        const LAS bf16* QN = T + hl * SLOT_C; const LAS bf16* KN = QN + T_NAT; const LAS bf16* VT = QN + 2 * T_NAT;
        const LAS float* sm = small + hl * 256;
        const int s = 16 * sb + r16;
        const float* ct = (const float*)(F.ws + WS_CLOC) + (size_t)item * CITEM;
        bf16x8 qf[4];
#pragma unroll
        for (int kk = 0; kk < 4; ++kk) qf[kk] = *(const LAS bf16x8*)(QN + s * NP + 32 * kk + 8 * q);
        f32x4 acc[8];
#pragma unroll
        for (int me = 0; me < 8; ++me) {
            acc[me] = (f32x4){0.f, 0.f, 0.f, 0.f};
#pragma unroll
            for (int kk = 0; kk < 4; ++kk) { const float* p = ct + (16 * me + r16) * HD + 32 * kk + 8 * q;
                acc[me] = MFMA16(pack8(*(const f32x4*)p, *(const f32x4*)(p + 4)), qf[kk], acc[me]); }
        }
        f32x4 accn = (f32x4){0.f, 0.f, 0.f, 0.f};
#pragma unroll
        for (int kk = 0; kk < 4; ++kk) { const float* p = ct + HD * HD + 32 * kk + 8 * q;
            f32x4 lo = *(const f32x4*)p, hi = *(const f32x4*)(p + 4);
            if (r16 != 0) { lo = (f32x4){0.f, 0.f, 0.f, 0.f}; hi = lo; }
            accn = MFMA16(pack8(lo, hi), qf[kk], accn); }
        const float qn = __shfl(accn[0], r16);
        const float iw = sm[128 + s];
#pragma unroll
        for (int me = 0; me < 8; ++me) acc[me] = acc[me] * iw;
        f32x4 S[4];
#pragma unroll
        for (int m = 0; m < 4; ++m) {
            S[m] = (f32x4){0.f, 0.f, 0.f, 0.f};
            if (m <= sb) {
#pragma unroll
                for (int kk = 0; kk < 4; ++kk) S[m] = MFMA16(*(const LAS bf16x8*)(KN + (16 * m + r16) * NP + 32 * kk + 8 * q), qf[kk], S[m]);
            }
        }
        const float bs = sm[64 + s];
        float rs = 0.f;
#pragma unroll
        for (int m = 0; m < 4; ++m) {
            if (m <= sb) {
                const f32x4 gj = *(const LAS f32x4*)(sm + 16 * m + 4 * q);
#pragma unroll
                for (int i = 0; i < 4; ++i) { const int j = 16 * m + 4 * q + i; const float p = (j <= s) ? __expf(bs + gj[i]) : 0.f; S[m][i] *= p; rs += S[m][i]; }
            }
        }
        rs += __shfl_xor(rs, 16); rs += __shfl_xor(rs, 32);
        const float dn = fmaxf(fabsf(rs + iw * qn), sm[192 + s]);
#pragma unroll
        for (int k2 = 0; k2 < 2; ++k2) {
            if (2 * k2 <= sb) {
                const bf16x8 pf = pack8(S[2 * k2], S[2 * k2 + 1]);
#pragma unroll
                for (int me = 0; me < 8; ++me) { const LAS bf16* vp = VT + (16 * me + r16) * TP + 32 * k2 + 4 * q;
                    const v2u va = *(const LAS v2u*)vp, vb = *(const LAS v2u*)(vp + 16);
                    const v4u vv = (v4u){va.x, va.y, vb.x, vb.y};
                    acc[me] = MFMA16(__builtin_bit_cast(bf16x8, vv), pf, acc[me]); }
            }
        }
        const bf16* proj = (const bf16*)(F.ws + WS_PROJ);
        bf16* Y = (bf16*)(F.ws + WS_XN);
        const float rdn = 1.f / dn;
        float ss = 0.f;
#pragma unroll
        for (int me = 0; me < 8; ++me) {
            const v2u ow = *(const v2u*)(proj + (row0 + s) * NPROJ + 2560 + hh * HD + 16 * me + 4 * q);
            const f32x4 og = unpk2(ow);
            f32x4 o; o.x = sigmoidf_(og.x); o.y = sigmoidf_(og.y); o.z = sigmoidf_(og.z); o.w = sigmoidf_(og.w);
            acc[me] = o * (acc[me] * rdn);
            ss += (acc[me].x * acc[me].x + acc[me].y * acc[me].y) + (acc[me].z * acc[me].z + acc[me].w * acc[me].w);
        }
        ss += __shfl_xor(ss, 16); ss += __shfl_xor(ss, 32);
        const float rstd = rsqrtf(ss * (1.f / HD) + EPS);
#pragma unroll
        for (int me = 0; me < 8; ++me) {
            const f32x4 gn = *(const f32x4*)(F.in[15] + hh * HD + 16 * me + 4 * q);
            const f32x4 y = acc[me] * rstd * gn;
            v2u w; w.x = pk2(y.x, y.y); w.y = pk2(y.z, y.w);
            *(v2u*)(Y + (row0 + s) * DM + DRG + hh * HD + 16 * me + 4 * q) = w;
        }
    }
    __syncthreads();
}

__device__ __forceinline__ void scan_phase(const Frame& F) {
    LAS float* L = (LAS float*)F.lds;
    LAS float* so = L; LAS float* sn = L + 1024;
    if (F.tid < 32) {
        const int bh = F.tid; float m = 0.f;
        const float* mloc = (const float*)(F.ws + WS_MLOC); const float* blast = (const float*)(F.ws + WS_BLAST); float* mprev = (float*)(F.ws + WS_MPREV);
        for (int c = 0; c < NCH; ++c) {
            const float ml = mloc[bh * NCH + c], bl = blast[bh * NCH + c];
            const float mn = fmaxf(bl + m, ml);
            so[bh * NCH + c] = __expf(bl + m - mn); sn[bh * NCH + c] = __expf(ml - mn);
            if (F.bid == 0) mprev[bh * NCH + c] = m;
            m = mn;
        }
    }
    __syncthreads();
    const int gt = F.bid * NTHR + F.tid, NGT = F.G * NTHR;
    constexpr int V4_PER_BH = CITEM / 4;
    for (int idx = gt; idx < 32 * V4_PER_BH; idx += NGT) {
        const int bh = idx / V4_PER_BH, off = idx % V4_PER_BH;
        f32x4* p = (f32x4*)((float*)(F.ws + WS_CLOC) + (size_t)bh * NCH * CITEM) + off;
        f32x4 st = (f32x4){0.f, 0.f, 0.f, 0.f};
#pragma unroll 8
        for (int c = 0; c < NCH; ++c) {
            const f32x4 cl = p[(size_t)c * V4_PER_BH];
            p[(size_t)c * V4_PER_BH] = st;
            st = so[bh * NCH + c] * st + sn[bh * NCH + c] * cl;
        }
    }
    if (gt < NB * DRG) {
        const int b = gt / DRG, c = gt % DRG;
        const float* A = (const float*)(F.ws + WS_RGA); const float* H = (const float*)(F.ws + WS_RGH); float* HI = (float*)(F.ws + WS_RGIN);
        float h = 0.f;
#pragma unroll 8
        for (int k = 0; k < NCH; ++k) { const int o = (b * NCH + k) * DRG + c; const float a = A[o], hh = H[o]; HI[o] = h; h = a * h + hh; }
    }
    __syncthreads();
}

__device__ __forceinline__ void norm1_phase(const Frame& F) {
    const int gw = F.bid * NWAVES + F.wave, NGW = F.G * NWAVES;
    const float* mix = (const float*)(F.ws + WS_CLOC); bf16* V = (bf16*)(F.ws + WS_PROJ);
    f32x4 g1[4], g2[4];
#pragma unroll
    for (int j = 0; j < 4; ++j) { g1[j] = *(const f32x4*)(F.in[17] + 256 * j + 4 * F.lane); g2[j] = *(const f32x4*)(F.in[18] + 256 * j + 4 * F.lane); }
    for (int m = gw; m < MT; m += NGW) {
        const f32x4* mr = (const f32x4*)(mix + (size_t)m * DM) + F.lane; const f32x4* xr = (const f32x4*)(F.in[0] + (size_t)m * DM) + F.lane;
        f32x4 v[4], xv[4]; float s = 0.f;
#pragma unroll
        for (int j = 0; j < 4; ++j) { v[j] = mr[64 * j]; xv[j] = xr[64 * j]; s += (v[j].x * v[j].x + v[j].y * v[j].y) + (v[j].z * v[j].z + v[j].w * v[j].w); }
        const float rstd = rsqrtf(wave_sum(s) * (1.f / DM) + EPS);
        float s2 = 0.f;
        f32x4* orow = (f32x4*)(F.out + (size_t)m * DM) + F.lane;
#pragma unroll
        for (int j = 0; j < 4; ++j) { v[j] = xv[j] + v[j] * rstd * g1[j]; orow[64 * j] = v[j]; s2 += (v[j].x * v[j].x + v[j].y * v[j].y) + (v[j].z * v[j].z + v[j].w * v[j].w); }
        const float rstd2 = rsqrtf(wave_sum(s2) * (1.f / DM) + EPS);
        unsigned long long* o8 = (unsigned long long*)(V + (size_t)m * DM) + F.lane;
#pragma unroll
        for (int j = 0; j < 4; ++j) { const f32x4 y = v[j] * rstd2 * g2[j]; o8[64 * j] = (unsigned long long)pk2(y.x, y.y) | ((unsigned long long)pk2(y.z, y.w) << 32); }
    }
}
__device__ __forceinline__ void norm2_phase(const Frame& F) {
    const int gw = F.bid * NWAVES + F.wave, NGW = F.G * NWAVES;
    const float* ffo = (const float*)(F.ws + WS_FFO);
    f32x4 g1[4];
#pragma unroll
    for (int j = 0; j < 4; ++j) g1[j] = *(const f32x4*)(F.in[21] + 256 * j + 4 * F.lane);
    for (int m = gw; m < MT; m += NGW) {
        const f32x4* mr = (const f32x4*)(ffo + (size_t)m * DM) + F.lane; f32x4* orow = (f32x4*)(F.out + (size_t)m * DM) + F.lane;
        f32x4 v[4], xv[4]; float s = 0.f;
#pragma unroll
        for (int j = 0; j < 4; ++j) { v[j] = mr[64 * j]; xv[j] = orow[64 * j]; s += (v[j].x * v[j].x + v[j].y * v[j].y) + (v[j].z * v[j].z + v[j].w * v[j].w); }
        const float rstd = rsqrtf(wave_sum(s) * (1.f / DM) + EPS);
#pragma unroll
        for (int j = 0; j < 4; ++j) orow[64 * j] = xv[j] + v[j] * rstd * g1[j];
    }
}

struct Args { const float* in[22]; float* out; unsigned char* ws; };
__global__ void __launch_bounds__(NTHR, 2) hymba_fwd(Args args) {
    extern __shared__ __attribute__((aligned(16))) unsigned char lds[];
    cg::grid_group grid = cg::this_grid();
    Frame F;
    F.lds = (LAS unsigned char*)lds;
    F.tid = threadIdx.x; F.lane = F.tid & 63; F.wave = __builtin_amdgcn_readfirstlane(F.tid >> 6);
    F.G = gridDim.x; F.bid = blockIdx.x;
#pragma unroll
    for (int i = 0; i < 22; ++i) F.in[i] = args.in[i];
    F.out = args.out; F.ws = args.ws;
    bf16* XN = (bf16*)(F.ws + WS_XN); bf16* PROJ = (bf16*)(F.ws + WS_PROJ);

#ifndef SKIP_P0
    p0_prologue(F);
#endif
    grid.sync();
    { pg8::Gemm g{XN, (const bf16*)(F.ws + WS_WIN), MT, NPROJ, DM}; pg8::StaticOrder S; S.init(MT, NPROJ, F.G, F.bid);
      pg8::EpiBf16<0> E{PROJ, NPROJ};
      pg8::gemm_phase<pg8::EpiBf16<0>, pg8::StaticOrder, true, true>(F.lds, g, S, E); }
    grid.sync();
    if (F.bid < NB * NCH) { const int it = F.bid; const int b = it / NCH, ch = it % NCH;
#ifndef SKIP_RG
        rg_pass<false>(F, b, ch);
#endif
#pragma unroll 1
        for (int r = 0; r < 2; ++r) {
#ifndef SKIP_MLA
            ml_local(F, b, ch, r);
#endif
        } }
    grid.sync();
#ifndef SKIP_SCAN
    scan_phase(F);
#endif
    grid.sync();
    if (F.bid < NB * NCH) { const int it = F.bid; const int b = it / NCH, ch = it % NCH;
#ifndef SKIP_RG
        rg_pass<true>(F, b, ch);
#endif
#pragma unroll 1
        for (int r = 0; r < 2; ++r) {
#ifndef SKIP_MLC
            ml_out(F, b, ch, r);
#endif
        } }
    grid.sync();
    { pg8::Gemm g{XN, (const bf16*)(F.ws + WS_WO), MT, DM, DM}; pg8::StaticOrder S; S.init(MT, DM, F.G, F.bid);
      pg8::EpiF32 E{(float*)(F.ws + WS_CLOC), DM};
      pg8::gemm_phase<pg8::EpiF32, pg8::StaticOrder, true, true>(F.lds, g, S, E); }
    grid.sync();
    norm1_phase(F);
    grid.sync();
    { pg8::Gemm g{PROJ, (const bf16*)(F.ws + WS_WUP), MT, FF, DM}; pg8::StaticOrder S; S.init(MT, FF, F.G, F.bid);
      pg8::EpiBf16<2> E{(bf16*)(F.ws + WS_H), FF};
      pg8::gemm_phase<pg8::EpiBf16<2>, pg8::StaticOrder, true, true>(F.lds, g, S, E); }
    grid.sync();
    { pg8::Gemm g{(const bf16*)(F.ws + WS_H), (const bf16*)(F.ws + WS_WDN), MT, DM, FF}; pg8::StaticOrder S; S.init(MT, DM, F.G, F.bid);
      pg8::EpiF32 E{(float*)(F.ws + WS_FFO), DM};
      pg8::gemm_phase<pg8::EpiF32, pg8::StaticOrder, true, true>(F.lds, g, S, E); }
    grid.sync();
    norm2_phase(F);
}

extern "C" void kernel_launch(void* const* d_in, const int* in_sizes, int n_in, void* d_out, int out_size, void* d_ws, size_t ws_size, hipStream_t stream) {
    static int grid = 0;
    if (grid == 0) {
        int dev = 0, cus = 0, per_cu = 0;
        hipGetDevice(&dev);
        hipDeviceGetAttribute(&cus, hipDeviceAttributeMultiprocessorCount, dev);
        hipFuncSetAttribute((const void*)hymba_fwd, hipFuncAttributeMaxDynamicSharedMemorySize, LDS_BYTES);
        hipOccupancyMaxActiveBlocksPerMultiprocessor(&per_cu, (const void*)hymba_fwd, NTHR, LDS_BYTES);
        if (per_cu < 1) { fprintf(stderr, "kernel_launch: occupancy query says %d blocks per CU\n", per_cu); per_cu = 1; }
        grid = cus;
        if (n_in != 22 || out_size != MT * DM || ws_size < 256 * MiB) fprintf(stderr, "kernel_launch: unexpected shapes n_in %d out %d ws %zu\n", n_in, out_size, ws_size);
    }
    Args a{};
    for (int i = 0; i < 22; ++i) a.in[i] = (const float*)d_in[i];
    a.out = (float*)d_out; a.ws = (unsigned char*)d_ws;
    void* kargs[] = {&a};
    hipError_t e = hipLaunchCooperativeKernel((const void*)hymba_fwd, dim3(grid), dim3(NTHR), kargs, LDS_BYTES, stream);
    if (e != hipSuccess) fprintf(stderr, "cooperative launch failed: %s (grid %d)\n", hipGetErrorString(e), grid);
}
```

```cpp
#include <hip/hip_runtime.h>
#include <hip/hip_cooperative_groups.h>
#include <cstdio>
#include <cstdint>
namespace cg = cooperative_groups;
namespace pg8 {
#define PG8_LAS __attribute__((address_space(3)))
typedef unsigned short bf16_t;
typedef short bf16x8 __attribute__((ext_vector_type(8)));
typedef float f32x4 __attribute__((ext_vector_type(4)));
typedef unsigned u32x4 __attribute__((ext_vector_type(4)));
constexpr int BM = 256, BK = 64, HALF = 128, HTB = HALF * BK * 2  , STAGE_BYTES = 8 * HTB, NXCD = 8, WGM = 8;

__host__ __device__ __forceinline__ int lds_byte(int r, int c) { const int st = (r >> 4) * 2 + (c >> 5), rr = r & 15, cc = c & 31, ob = rr * 64 + cc * 2; return st * 1024 + (ob ^ (((ob >> 9) & 1) << 5)); }
__host__ __device__ __forceinline__ void stage_rc(int b, int& R, int& C) { const int st = b / 1024, sb = b % 1024, swz = sb ^ (((sb >> 9) & 1) << 5); R = (st >> 1) * 16 + swz / 64; C = (st & 1) * 32 + (swz % 64) / 2; }
__host__ __device__ __forceinline__ int perm32(int rho) { const int n = rho >> 4, i = rho & 15; return 8 * (i >> 2) + 4 * n + (i & 3); }

struct Unit { int pm, pn; };
struct Gemm { const bf16_t* A; const bf16_t* Bt; int M, N, K; };

struct StaticOrder {
    int nM, nN, nwg, G, c;
    __host__ __device__ void init(int M, int N, int G_, int c_) { nM = M / BM; nN = N / BM; nwg = nM * nN; G = G_; c = c_; }
    __host__ __device__ bool next(int i, Unit& u) const {
        const long L = (long)i * G + c; if (L >= nwg) return false;
        int wgid = (int)L; { const int q = nwg / NXCD, r = nwg % NXCD, xcd = wgid % NXCD, off = wgid / NXCD; wgid = (xcd < r ? xcd * (q + 1) : r * (q + 1) + (xcd - r) * q) + off; }
        const int nig = WGM * nN, gid = wgid / nig, fm = gid * WGM, gsz = (nM - fm) < WGM ? (nM - fm) : WGM;
        u.pm = fm + ((wgid % nig) % gsz); u.pn = (wgid % nig) / gsz; return true;
    }
    __device__ __forceinline__ void a_ready(const Unit&) const {}
    __device__ __forceinline__ void done(const Unit&) const {}
};

__device__ __forceinline__ unsigned cvt_pk_bf16(float lo, float hi) { unsigned r; asm volatile("v_cvt_pk_bf16_f32 %0, %1, %2" : "=v"(r) : "v"(lo), "v"(hi)); return r; }
template <int ACT> struct EpiBf16 {
    static constexpr bool PERM = true, AFTER_DRAIN = false;
    bf16_t* O; int ldc;
    __device__ __forceinline__ void operator()(const f32x4 (&acc)[2][2][4][2], const Unit& u, int wr, int wc, int fr, int fq) const {
        const int row0 = u.pm * BM + wr * 64 + fr; const int col0 = u.pn * BM + wc * 32 + 8 * fq;
#pragma unroll
        for (int ai = 0; ai < 2; ++ai)
#pragma unroll
            for (int m = 0; m < 4; ++m) { bf16_t* rowp = O + (size_t)(row0 + ai * HALF + m * 16) * ldc + col0;
#pragma unroll
                for (int bj = 0; bj < 2; ++bj) { f32x4 v0 = acc[ai][bj][m][0], v1 = acc[ai][bj][m][1];
                    if (ACT == 2) {
#pragma unroll
                        for (int e = 0; e < 4; ++e) { float a = fmaxf(v0[e], 0.f), b = fmaxf(v1[e], 0.f); v0[e] = a * a; v1[e] = b * b; } }
                    u32x4 w; w.x = cvt_pk_bf16(v0[0], v0[1]); w.y = cvt_pk_bf16(v0[2], v0[3]); w.z = cvt_pk_bf16(v1[0], v1[1]); w.w = cvt_pk_bf16(v1[2], v1[3]);
                    *(u32x4*)(rowp + bj * HALF) = w; } }
    }
};
struct EpiF32 {
    static constexpr bool PERM = false, AFTER_DRAIN = false;
    float* O; int ldc;
    __device__ __forceinline__ void operator()(const f32x4 (&acc)[2][2][4][2], const Unit& u, int wr, int wc, int fr, int fq) const {
        const int col0 = u.pn * BM + wc * 32 + 4 * fq;
#pragma unroll
        for (int ai = 0; ai < 2; ++ai)
#pragma unroll
            for (int m = 0; m < 4; ++m) { const int r = u.pm * BM + ai * HALF + wr * 64 + m * 16 + fr; float* rowp = O + (size_t)r * ldc + col0;
#pragma unroll
                for (int bj = 0; bj < 2; ++bj)
#pragma unroll
                    for (int n = 0; n < 2; ++n) *(f32x4*)(rowp + bj * HALF + n * 16) = acc[ai][bj][m][n]; }
    }
};
template <class Epi, class Sched, bool ALIGN_EPI = false, bool SP2 = false>
__device__ __forceinline__ void gemm_phase(PG8_LAS unsigned char* lds, const Gemm g, const Sched& S, const Epi& E) {
    const int tid = threadIdx.x, wid = __builtin_amdgcn_readfirstlane(tid >> 6), lane = tid & 63, wr = wid >> 2, wc = wid & 3, fr = lane & 15, fq = lane >> 4;
    const int K = g.K, nt = K / BK;
    unsigned voffA[2], voffB[2];
#pragma unroll
    for (int i = 0; i < 2; ++i) { int R, C; stage_rc(tid * 16 + i * 8192, R, C); const int Rb = Epi::PERM ? ((R & ~31) + perm32(R & 31)) : R;
        voffA[i] = (unsigned)(R * K + C) * 2u; voffB[i] = (unsigned)(Rb * K + C) * 2u; }
    const size_t kstep = (size_t)(BK * 2);
    const size_t hstep = (size_t)HALF * K * 2;
    const size_t tstep = 2 * hstep;
    const unsigned ldsw = (unsigned)wid * 1024u;
    const int aoff = lds_byte(wr * 64 + fr, fq * 8), boff = lds_byte(wc * 32 + fr, fq * 8);
#define PG8_SA(b, h) (((b) * 2 + (h)) * HTB)
#define PG8_SB(b, h) ((4 + (b) * 2 + (h)) * HTB)
#define PG8_STAGE(bufoff, gbase, voff) do { _Pragma("unroll") for (int _i = 0; _i < 2; ++_i) \
        __builtin_amdgcn_global_load_lds((const unsigned*)((const char*)(gbase) + (voff)[_i]), (PG8_LAS unsigned*)(lds + (bufoff) + ldsw + _i * 8192), 16, 0, 0); } while (0)
#define PG8_LDA(dst, b, h) do { _Pragma("unroll") for (int m = 0; m < 4; ++m) _Pragma("unroll") for (int k = 0; k < 2; ++k) dst[m][k] = *(const PG8_LAS bf16x8*)(lds + PG8_SA(b, h) + aoff + m * 2048 + k * 1024); } while (0)
#define PG8_LDB(dst, b, h) do { _Pragma("unroll") for (int n = 0; n < 2; ++n) _Pragma("unroll") for (int k = 0; k < 2; ++k) dst[n][k] = *(const PG8_LAS bf16x8*)(lds + PG8_SB(b, h) + boff + n * 2048 + k * 1024); } while (0)
#define PG8_MMA(ai, bj, At, Bt) do { __builtin_amdgcn_s_setprio(1); _Pragma("unroll") for (int m = 0; m < 4; ++m) _Pragma("unroll") for (int n = 0; n < 2; ++n) _Pragma("unroll") for (int k = 0; k < 2; ++k) \
        acc[ai][bj][m][n] = __builtin_amdgcn_mfma_f32_16x16x32_bf16(Bt[n][k], At[m][k], acc[ai][bj][m][n], 0, 0, 0); __builtin_amdgcn_s_setprio(0); } while (0)
#define PG8_WAIT_V(n) asm volatile("s_waitcnt vmcnt(" #n ")" ::: "memory")
#define PG8_WAIT_L(n) asm volatile("s_waitcnt lgkmcnt(" #n ")" ::: "memory")
#define PG8_BAR __builtin_amdgcn_s_barrier()
#define PG8_SCHED __builtin_amdgcn_sched_barrier(0)
    Unit cur, nxt; int ui = 0;
    if (!S.next(0, cur)) return;
    f32x4 acc[2][2][4][2];
#pragma unroll
    for (int a = 0; a < 2; ++a)
#pragma unroll
        for (int b = 0; b < 2; ++b)
#pragma unroll
            for (int m = 0; m < 4; ++m)
#pragma unroll
                for (int n = 0; n < 2; ++n) acc[a][b][m][n] = (f32x4){0.f, 0.f, 0.f, 0.f};
    bf16x8 At[4][2], B0[2][2], B1[2][2];
    const char* cA = (const char*)g.A + (size_t)cur.pm * tstep; const char* cB = (const char*)g.Bt + (size_t)cur.pn * tstep;
    S.a_ready(cur);
    if constexpr (SP2) {
        PG8_STAGE(PG8_SB(0, 0), cB, voffB); PG8_STAGE(PG8_SB(0, 1), cB + hstep, voffB); PG8_STAGE(PG8_SA(0, 0), cA, voffA); PG8_STAGE(PG8_SA(0, 1), cA + hstep, voffA);
        if (wr == 1) PG8_BAR;
        PG8_WAIT_V(2); PG8_BAR;
        PG8_STAGE(PG8_SB(1, 0), cB + kstep, voffB); PG8_STAGE(PG8_SA(1, 0), cA + kstep, voffA); PG8_STAGE(PG8_SB(1, 1), cB + hstep + kstep, voffB);
        PG8_WAIT_V(6); PG8_BAR;
    } else {
        PG8_STAGE(PG8_SB(0, 0), cB, voffB); PG8_STAGE(PG8_SA(0, 0), cA, voffA); PG8_STAGE(PG8_SB(0, 1), cB + hstep, voffB); PG8_STAGE(PG8_SA(0, 1), cA + hstep, voffA);
        if (wr == 1) PG8_BAR;
        PG8_WAIT_V(4); PG8_BAR;
        PG8_STAGE(PG8_SB(1, 0), cB + kstep, voffB); PG8_STAGE(PG8_SA(1, 0), cA + kstep, voffA); PG8_STAGE(PG8_SB(1, 1), cB + hstep + kstep, voffB);
        PG8_WAIT_V(6); PG8_BAR;
    }
    for (;;) {
        const bool has_next = S.next(ui + 1, nxt);
        const char* nA = has_next ? (const char*)g.A + (size_t)nxt.pm * tstep : cA; const char* nB = has_next ? (const char*)g.Bt + (size_t)nxt.pn * tstep : cB;
        for (int t = 0; t < nt; t += 2) {
            const bool last = (t == nt - 2);
            const char* a1 = cA + (size_t)(t + 1) * kstep;
            const char* a2 = last ? nA : cA + (size_t)(t + 2) * kstep; const char* b2 = last ? nB : cB + (size_t)(t + 2) * kstep;
            const char* a3 = a2 + kstep; const char* b3 = b2 + kstep;
            if (last && has_next) S.a_ready(nxt);
            if constexpr (SP2) {
            PG8_LDB(B0, 0, 0); PG8_LDB(B1, 0, 1); PG8_SCHED; PG8_LDA(At, 0, 0); PG8_STAGE(PG8_SA(1, 1), a1 + hstep, voffA);
            PG8_WAIT_V(8); PG8_WAIT_L(0); PG8_BAR; PG8_MMA(0, 0, At, B0); PG8_MMA(0, 1, At, B1); PG8_BAR; PG8_SCHED;
            PG8_LDA(At, 0, 1); PG8_STAGE(PG8_SB(0, 0), b2, voffB); PG8_STAGE(PG8_SB(0, 1), b2 + hstep, voffB); PG8_STAGE(PG8_SA(0, 0), a2, voffA);
            PG8_WAIT_V(8); PG8_WAIT_L(0); PG8_BAR; PG8_MMA(1, 0, At, B0); PG8_MMA(1, 1, At, B1); PG8_BAR; PG8_SCHED;
            PG8_LDB(B0, 1, 0); PG8_LDB(B1, 1, 1); PG8_SCHED; PG8_LDA(At, 1, 0); PG8_STAGE(PG8_SA(0, 1), a2 + hstep, voffA);
            PG8_WAIT_V(8); PG8_WAIT_L(0); PG8_BAR; PG8_MMA(0, 0, At, B0); PG8_MMA(0, 1, At, B1); PG8_BAR; PG8_SCHED;
            PG8_LDA(At, 1, 1); PG8_STAGE(PG8_SB(1, 0), b3, voffB); PG8_STAGE(PG8_SB(1, 1), b3 + hstep, voffB); PG8_STAGE(PG8_SA(1, 0), a3, voffA);
            PG8_WAIT_V(8); PG8_WAIT_L(0); PG8_BAR; PG8_MMA(1, 0, At, B0); PG8_MMA(1, 1, At, B1); PG8_BAR; PG8_SCHED;
            } else {
            PG8_LDB(B0, 0, 0); PG8_SCHED; PG8_LDA(At, 0, 0); PG8_STAGE(PG8_SA(1, 1), a1 + hstep, voffA);
            PG8_WAIT_L(8); PG8_BAR; PG8_WAIT_L(0); PG8_MMA(0, 0, At, B0); PG8_BAR; PG8_SCHED;
            PG8_LDB(B1, 0, 1); PG8_STAGE(PG8_SB(0, 0), b2, voffB);
            PG8_BAR; PG8_WAIT_L(0); PG8_MMA(0, 1, At, B1); PG8_BAR;
            PG8_LDA(At, 0, 1); PG8_STAGE(PG8_SA(0, 0), a2, voffA);
            PG8_BAR; PG8_WAIT_L(0); PG8_MMA(1, 0, At, B0); PG8_BAR; PG8_SCHED;
            PG8_STAGE(PG8_SB(0, 1), b2 + hstep, voffB);
            PG8_WAIT_V(6); PG8_BAR; PG8_MMA(1, 1, At, B1); PG8_BAR;
            PG8_LDB(B0, 1, 0); PG8_SCHED; PG8_LDA(At, 1, 0); PG8_STAGE(PG8_SA(0, 1), a2 + hstep, voffA);
            PG8_WAIT_L(8); PG8_BAR; PG8_WAIT_L(0); PG8_MMA(0, 0, At, B0); PG8_BAR; PG8_SCHED;
            PG8_LDB(B1, 1, 1); PG8_STAGE(PG8_SB(1, 0), b3, voffB);
            PG8_BAR; PG8_WAIT_L(0); PG8_MMA(0, 1, At, B1); PG8_BAR;
            PG8_LDA(At, 1, 1); PG8_STAGE(PG8_SA(1, 0), a3, voffA);
            PG8_BAR; PG8_WAIT_L(0); PG8_MMA(1, 0, At, B0); PG8_BAR; PG8_SCHED;
            PG8_STAGE(PG8_SB(1, 1), b3 + hstep, voffB);
            PG8_WAIT_V(6); PG8_BAR; PG8_MMA(1, 1, At, B1); PG8_BAR;
            }
        }
        if constexpr (ALIGN_EPI) { if (wr == 0) PG8_BAR; }
        if constexpr (!Epi::AFTER_DRAIN) { E(acc, cur, wr, wc, fr, fq); S.done(cur); }
        if (!has_next) break;
#pragma unroll
        for (int a = 0; a < 2; ++a)
#pragma unroll
            for (int b = 0; b < 2; ++b)
#pragma unroll
                for (int m = 0; m < 4; ++m)
#pragma unroll
                    for (int n = 0; n < 2; ++n) acc[a][b][m][n] = (f32x4){0.f, 0.f, 0.f, 0.f};
        cur = nxt; cA = nA; cB = nB; ++ui;
        if constexpr (ALIGN_EPI) { if (wr == 1) PG8_BAR; }
    }
    PG8_WAIT_V(0);
    if constexpr (!ALIGN_EPI) { if (wr == 0) PG8_BAR; }
    PG8_BAR;
    if constexpr (Epi::AFTER_DRAIN) { E.fused(acc, cur, wr, wc, fr, fq, lds, wid, lane); S.done(cur); }
#undef PG8_SA
#undef PG8_SB
#undef PG8_STAGE
#undef PG8_LDA
#undef PG8_LDB
#undef PG8_MMA
#undef PG8_WAIT_V
#undef PG8_WAIT_L
#undef PG8_BAR
#undef PG8_SCHED
}
}

constexpr int NB = 8, SEQ = 2048, DM = 1024, MT = NB * SEQ, DIN = 3080, NPROJ = 3072, FF = 4096;
constexpr int NCH = 32, CL = 64, NH = 4, HD = 128, DRG = 512;
constexpr float EPS = 1e-6f;
constexpr int NWAVES = 8, NTHR = 512;
constexpr size_t MiB = 1u << 20;
constexpr size_t WS_WIN = 1 * MiB, WS_WO = 7 * MiB, WS_WUP = 9 * MiB, WS_WDN = 17 * MiB;
constexpr size_t WS_GATES = 25 * MiB;
constexpr size_t WS_RGA = 26 * MiB, WS_RGH = 26 * MiB + 512 * 1024, WS_RGIN = 27 * MiB;
constexpr size_t WS_MLOC = 28 * MiB, WS_BLAST = 28 * MiB + 65536, WS_MPREV = 28 * MiB + 131072;
constexpr size_t WS_XN = 32 * MiB;
constexpr size_t WS_PROJ = 64 * MiB;
constexpr size_t WS_CLOC = 160 * MiB;
constexpr size_t WS_H = 96 * MiB;
constexpr size_t WS_FFO = 32 * MiB;
constexpr int CITEM = 129 * 128;
constexpr int LDS_BYTES = 147456;

#define LAS __attribute__((address_space(3)))
typedef unsigned short bf16;
typedef unsigned v4u __attribute__((ext_vector_type(4)));
typedef unsigned v2u __attribute__((ext_vector_type(2)));
typedef float f32x4 __attribute__((ext_vector_type(4)));
#define LDS_WAIT() asm volatile("s_waitcnt lgkmcnt(0)" ::: "memory")
__device__ __forceinline__ unsigned f2bf(float f) { unsigned u = __builtin_bit_cast(unsigned, f); return (u + 0x7fffu + ((u >> 16) & 1u)) >> 16; }
__device__ __forceinline__ unsigned pk2(float lo, float hi) { return f2bf(lo) | (f2bf(hi) << 16); }
__device__ __forceinline__ float bf2f(bf16 u) { return __builtin_bit_cast(float, (unsigned)u << 16); }
__device__ __forceinline__ float wave_sum(float v) {
#pragma unroll
    for (int o = 1; o < 64; o <<= 1) v += __shfl_xor(v, o);
    return v;
}
__device__ __forceinline__ float wave_max(float v) {
#pragma unroll
    for (int o = 1; o < 64; o <<= 1) v = fmaxf(v, __shfl_xor(v, o));
    return v;
}
__device__ __forceinline__ float sigmoidf_(float z) { return 1.f / (1.f + __expf(-z)); }
__device__ __forceinline__ float logsigmoidf_(float z) { return fminf(z, 0.f) - log1pf(__expf(-fabsf(z))); }
__device__ __forceinline__ float gelu_tanh(float v) { const float u = 0.7978845608028654f * (v + 0.044715f * v * v * v); return 0.5f * v * (1.f + tanhf(u)); }
__device__ __forceinline__ float rdlane(float v, int l) { return __builtin_bit_cast(float, __builtin_amdgcn_readlane(__builtin_bit_cast(int, v), l)); }

struct Frame {
    LAS unsigned char* lds;
    int tid, lane, wave, G, bid;
    const float* in[22]; float* out; unsigned char* ws;
};

__device__ __forceinline__ void p0_transpose_item(const float* W, int K, int ldw, int nblk, bf16* WT, LAS float* scr, int item, int lane) {
    const int kb = item / nblk, nb = item % nblk, k0 = 64 * kb, n0 = 32 * nb;
#pragma unroll 8
    for (int i = 0; i < 32; ++i) { const int kk = 2 * i + (lane >> 5); scr[kk * 33 + (lane & 31)] = W[(size_t)(k0 + kk) * ldw + n0 + (lane & 31)]; }
    LDS_WAIT(); asm volatile("" ::: "memory");
    const int c = lane & 7;
#pragma unroll
    for (int j = 0; j < 4; ++j) { const int n = (lane >> 3) + 8 * j; const LAS float* s = scr + (8 * c) * 33 + n;
        v4u o; o.x = pk2(s[0 * 33], s[1 * 33]); o.y = pk2(s[2 * 33], s[3 * 33]); o.z = pk2(s[4 * 33], s[5 * 33]); o.w = pk2(s[6 * 33], s[7 * 33]);
        *(v4u*)(WT + (size_t)(n0 + n) * K + k0 + 8 * c) = o; }
    LDS_WAIT(); asm volatile("" ::: "memory");
}

__device__ __forceinline__ void p0_prologue(const Frame& F) {
    LAS float* scr = (LAS float*)(F.lds + F.wave * 16384);
    const int gw = F.bid * NWAVES + F.wave, NGW = F.G * NWAVES;
    constexpr int I_IN = (DM / 64) * (NPROJ / 32), I_O = (DM / 64) * (DM / 32), I_UP = (DM / 64) * (FF / 32), I_DN = (FF / 64) * (DM / 32);
    constexpr int NITEMS = I_IN + I_O + I_UP + I_DN;
    bf16* win_t = (bf16*)(F.ws + WS_WIN); bf16* wo_t = (bf16*)(F.ws + WS_WO); bf16* wup_t = (bf16*)(F.ws + WS_WUP); bf16* wdn_t = (bf16*)(F.ws + WS_WDN);
    for (int it = gw; it < NITEMS; it += NGW) {
        int r = it;
        if (r < I_IN) { p0_transpose_item(F.in[2], DM, DIN, NPROJ / 32, win_t, scr, r, F.lane); continue; } r -= I_IN;
        if (r < I_O) { p0_transpose_item(F.in[16], DM, DM, DM / 32, wo_t, scr, r, F.lane); continue; } r -= I_O;
        if (r < I_UP) { p0_transpose_item(F.in[19], DM, FF, FF / 32, wup_t, scr, r, F.lane); continue; } r -= I_UP;
        p0_transpose_item(F.in[20], FF, DM, DM / 32, wdn_t, scr, r, F.lane);
    }
    __syncthreads();
    LAS float* wg = (LAS float*)F.lds;
    for (int e = F.tid; e < 8 * DM; e += NTHR) { const int k = e >> 3, n = e & 7; wg[n * DM + k] = F.in[2][(size_t)k * DIN + NPROJ + n]; }
    __syncthreads();
    const float* x = F.in[0]; bf16* xn = (bf16*)(F.ws + WS_XN); float* gates = (float*)(F.ws + WS_GATES);
    f32x4 gn[4];
#pragma unroll
    for (int j = 0; j < 4; ++j) gn[j] = *(const f32x4*)(F.in[1] + 256 * j + 4 * F.lane);
    for (int m = gw; m < MT; m += NGW) {
        const f32x4* xr = (const f32x4*)(x + (size_t)m * DM) + F.lane;
        f32x4 v[4]; float s = 0.f;
#pragma unroll
        for (int j = 0; j < 4; ++j) { v[j] = xr[64 * j]; s += (v[j].x * v[j].x + v[j].y * v[j].y) + (v[j].z * v[j].z + v[j].w * v[j].w); }
        const float rstd = rsqrtf(wave_sum(s) * (1.f / DM) + EPS);
        unsigned long long* o8 = (unsigned long long*)(xn + (size_t)m * DM) + F.lane;
        float ga[8];
#pragma unroll
        for (int n = 0; n < 8; ++n) ga[n] = 0.f;
#pragma unroll
        for (int j = 0; j < 4; ++j) {
            v[j] = v[j] * rstd * gn[j];
            o8[64 * j] = (unsigned long long)pk2(v[j].x, v[j].y) | ((unsigned long long)pk2(v[j].z, v[j].w) << 32);
#pragma unroll
            for (int n = 0; n < 8; ++n) { const f32x4 w = *(const LAS f32x4*)(wg + n * DM + 256 * j + 4 * F.lane);
                ga[n] += (v[j].x * w.x + v[j].y * w.y) + (v[j].z * w.z + v[j].w * w.w); }
        }
#pragma unroll
        for (int n = 0; n < 8; ++n) ga[n] = wave_sum(ga[n]);
        if (F.lane == 0) { *(f32x4*)(gates + (size_t)m * 8) = (f32x4){ga[0], ga[1], ga[2], ga[3]}; *(f32x4*)(gates + (size_t)m * 8 + 4) = (f32x4){ga[4], ga[5], ga[6], ga[7]}; }
    }
    __syncthreads();
}

typedef short bf16x8 __attribute__((ext_vector_type(8)));
#define MFMA16(a, b, c) __builtin_amdgcn_mfma_f32_16x16x32_bf16(a, b, c, 0, 0, 0)
__device__ __forceinline__ bf16x8 pack8(f32x4 lo, f32x4 hi) { v4u o; o.x = pk2(lo.x, lo.y); o.y = pk2(lo.z, lo.w); o.z = pk2(hi.x, hi.y); o.w = pk2(hi.z, hi.w); return __builtin_bit_cast(bf16x8, o); }
__device__ __forceinline__ f32x4 unpk_lo(v4u r) { return (f32x4){__builtin_bit_cast(float, r.x << 16), __builtin_bit_cast(float, r.x & 0xffff0000u), __builtin_bit_cast(float, r.y << 16), __builtin_bit_cast(float, r.y & 0xffff0000u)}; }
__device__ __forceinline__ f32x4 unpk_hi(v4u r) { return (f32x4){__builtin_bit_cast(float, r.z << 16), __builtin_bit_cast(float, r.z & 0xffff0000u), __builtin_bit_cast(float, r.w << 16), __builtin_bit_cast(float, r.w & 0xffff0000u)}; }
__device__ __forceinline__ f32x4 unpk2(v2u r) { return (f32x4){__builtin_bit_cast(float, r.x << 16), __builtin_bit_cast(float, r.x & 0xffff0000u), __builtin_bit_cast(float, r.y << 16), __builtin_bit_cast(float, r.y & 0xffff0000u)}; }

constexpr int VP = 516;

template <bool FINAL>
__device__ __forceinline__ void rg_pass(const Frame& F, int b, int ch) {
    const int l = F.lane, q = l >> 4, r16 = l & 15, g = F.wave;
    const bf16* proj = (const bf16*)(F.ws + WS_PROJ);
    const size_t row0 = (size_t)(b * SEQ + ch * CL);
    LAS float* val = (LAS float*)F.lds;
    bf16x8 xa[4][2];
#pragma unroll
    for (int kk = 0; kk < 2; ++kk) {
        const int c8 = 64 * g + 32 * kk + 8 * q;
        f32x4 cw[4][2];
#pragma unroll
        for (int tap = 0; tap < 4; ++tap) { cw[tap][0] = *(const f32x4*)(F.in[3] + tap * DRG + c8); cw[tap][1] = *(const f32x4*)(F.in[3] + tap * DRG + c8 + 4); }
        const f32x4 cb0 = *(const f32x4*)(F.in[4] + c8), cb1 = *(const f32x4*)(F.in[4] + c8 + 4);
#pragma unroll
        for (int m = 0; m < 4; ++m) {
            const int t = 16 * m + r16;
            const bf16* p = proj + (row0 + t) * NPROJ + c8;
            f32x4 lo = cb0, hi = cb1;
#pragma unroll
            for (int tap = 0; tap < 4; ++tap) {
                const int dt = tap - 3;
                const bool ok = (ch > 0) || (t + dt >= 0);
                const bf16* pp = ok ? (p + (ptrdiff_t)dt * NPROJ) : p;
                v4u raw = *(const v4u*)pp;
                if (!ok) raw = (v4u){0u, 0u, 0u, 0u};
                lo += cw[tap][0] * unpk_lo(raw); hi += cw[tap][1] * unpk_hi(raw);
            }
            xa[m][kk] = pack8(lo, hi);
        }
    }
    const float* pwr = F.in[5]; const float* pwi = F.in[7];
#pragma unroll 1
    for (int j = 0; j < 4; ++j) {
        const int cj = 64 * g + 16 * j + r16;
        bf16 gt[4][4];
        if (FINAL) {
#pragma unroll
            for (int m = 0; m < 4; ++m)
#pragma unroll
                for (int i = 0; i < 4; ++i) gt[m][i] = proj[(row0 + 16 * m + 4 * q + i) * NPROJ + DRG + cj];
        }
        bf16x8 wrf[2], wif[2];
#pragma unroll
        for (int kk = 0; kk < 2; ++kk) {
            const float* pr = pwr + (size_t)((g * 64 + 32 * kk + 8 * q) * 64 + 16 * j + r16);
            const float* pi = pwi + (size_t)((g * 64 + 32 * kk + 8 * q) * 64 + 16 * j + r16);
            wrf[kk] = pack8((f32x4){pr[0], pr[64], pr[128], pr[192]}, (f32x4){pr[256], pr[320], pr[384], pr[448]});
            wif[kk] = pack8((f32x4){pi[0], pi[64], pi[128], pi[192]}, (f32x4){pi[256], pi[320], pi[384], pi[448]});
        }
        const int e1 = r16 - 8 * (q - 2 * (j & 1));
        v4u idv;
        idv.x = (e1 == 0 ? 0x3F80u : 0u) | (e1 == 1 ? 0x3F800000u : 0u); idv.y = (e1 == 2 ? 0x3F80u : 0u) | (e1 == 3 ? 0x3F800000u : 0u);
        idv.z = (e1 == 4 ? 0x3F80u : 0u) | (e1 == 5 ? 0x3F800000u : 0u); idv.w = (e1 == 6 ? 0x3F80u : 0u) | (e1 == 7 ? 0x3F800000u : 0u);
        const bf16x8 idf = __builtin_bit_cast(bf16x8, idv);
        const float br = F.in[6][cj], bi = F.in[8][cj];
        const float zl = -F.in[9][cj];
        const float sp8 = 8.f * (fmaxf(zl, 0.f) + log1pf(__expf(-fabsf(zl))));
        float hrun = 0.f, Aall = 1.f;
        if (FINAL) hrun = ((const float*)(F.ws + WS_RGIN))[(b * NCH + ch) * DRG + cj];
#pragma unroll
        for (int m = 0; m < 4; ++m) {
            f32x4 ar = (f32x4){0.f, 0.f, 0.f, 0.f}, ai = ar, ax = ar;
            ar = MFMA16(xa[m][0], wrf[0], ar); ar = MFMA16(xa[m][1], wrf[1], ar);
            ai = MFMA16(xa[m][0], wif[0], ai); ai = MFMA16(xa[m][1], wif[1], ai);
            const bf16x8 xid = (j & 2) ? xa[m][1] : xa[m][0];
            ax = MFMA16(xid, idf, ax);
            float a[4], bb[4];
#pragma unroll
            for (int i = 0; i < 4; ++i) {
                const float r = sigmoidf_(ar[i] + br), ig = sigmoidf_(ai[i] + bi);
                const float la = -sp8 * r;
                a[i] = __expf(la);
                bb[i] = sqrtf(-expm1f(2.f * la)) * (ig * ax[i]);
            }
            const float Am = (a[0] * a[1]) * (a[2] * a[3]);
            const float Bm = ((bb[0] * a[1] + bb[1]) * a[2] + bb[2]) * a[3] + bb[3];
            float hstart = 0.f;
#pragma unroll
            for (int q2 = 0; q2 < 4; ++q2) {
                const float Aq = __shfl(Am, r16 + 16 * q2), Bq = __shfl(Bm, r16 + 16 * q2);
                if (q == q2) hstart = hrun;
                hrun = Aq * hrun + Bq;
                if (!FINAL) Aall *= Aq;
            }
            if (FINAL) {
                float h = hstart;
#pragma unroll
                for (int i = 0; i < 4; ++i) { h = a[i] * h + bb[i]; val[(16 * m + 4 * q + i) * VP + cj] = h * gelu_tanh(bf2f(gt[m][i])); }
            }
        }
        if (!FINAL && q == 0) {
            ((float*)(F.ws + WS_RGA))[(b * NCH + ch) * DRG + cj] = Aall;
            ((float*)(F.ws + WS_RGH))[(b * NCH + ch) * DRG + cj] = hrun;
        }
    }
    if (FINAL) {
        __syncthreads();
        bf16* Y = (bf16*)(F.ws + WS_XN);
        const f32x4 g0 = *(const f32x4*)(F.in[14] + 8 * F.lane), g1 = *(const f32x4*)(F.in[14] + 8 * F.lane + 4);
#pragma unroll 2
        for (int tt = 0; tt < 8; ++tt) {
            const int t = F.wave * 8 + tt;
            const f32x4 a0 = *(const LAS f32x4*)(val + t * VP + 8 * F.lane), a1 = *(const LAS f32x4*)(val + t * VP + 8 * F.lane + 4);
            float s = (a0.x * a0.x + a0.y * a0.y) + (a0.z * a0.z + a0.w * a0.w) + (a1.x * a1.x + a1.y * a1.y) + (a1.z * a1.z + a1.w * a1.w);
            const float rstd = rsqrtf(wave_sum(s) * (1.f / DRG) + EPS);
            const f32x4 y0 = a0 * rstd * g0, y1 = a1 * rstd * g1;
            v4u o; o.x = pk2(y0.x, y0.y); o.y = pk2(y0.z, y0.w); o.z = pk2(y1.x, y1.y); o.w = pk2(y1.z, y1.w);
            *(v4u*)(Y + (row0 + t) * DM + 8 * F.lane) = o;
        }
        __syncthreads();
    }
}

constexpr int TP = 72;
constexpr int NP = 136;
constexpr int T_NAT = 64 * NP, T_TR = 128 * TP;
constexpr int SLOT_A = 2 * T_TR;
constexpr int SLOT_C = 2 * T_NAT + T_TR;
constexpr int SM_OFF_BYTES = 2 * SLOT_C * 2;
static_assert(SM_OFF_BYTES + 4096 <= 131072 && 2 * SLOT_A * 2 <= SM_OFF_BYTES, "lds");

template <bool CONV, bool KW, bool TR>
__device__ __forceinline__ void ml_stage(const Frame& F, int b, int ch, int col0, int cc0, float scl, const LAS float* kw, LAS bf16* dst) {
    const int d = F.tid & 127, tq = F.tid >> 7;
    const bf16* proj = (const bf16*)(F.ws + WS_PROJ);
    const bf16* p = proj + (size_t)(b * SEQ + ch * CL + 16 * tq) * NPROJ + col0 + d;
    bf16 raw[19];
    const bool has_halo = (ch > 0) || (tq > 0);
#pragma unroll
    for (int u = 0; u < 16; ++u) raw[3 + u] = p[(size_t)u * NPROJ];
    float v[16];
    if (CONV) {
#pragma unroll
        for (int u = 0; u < 3; ++u) raw[u] = has_halo ? *(p - (ptrdiff_t)(3 - u) * NPROJ) : (bf16)0;
        const float w0 = F.in[10][cc0 + d], w1 = F.in[10][DM + cc0 + d], w2 = F.in[10][2 * DM + cc0 + d], w3 = F.in[10][3 * DM + cc0 + d], bb = F.in[11][cc0 + d];
#pragma unroll
        for (int u = 0; u < 16; ++u) {
            float x = bb + w0 * bf2f(raw[u]) + w1 * bf2f(raw[u + 1]) + w2 * bf2f(raw[u + 2]) + w3 * bf2f(raw[u + 3]);
            x = x * sigmoidf_(x) * scl;
            if (KW) x *= kw[16 * tq + u];
            v[u] = x;
        }
    } else {
#pragma unroll
        for (int u = 0; u < 16; ++u) v[u] = bf2f(raw[3 + u]);
    }
    if (TR) {
        v4u o0, o1;
        o0.x = pk2(v[0], v[1]); o0.y = pk2(v[2], v[3]); o0.z = pk2(v[4], v[5]); o0.w = pk2(v[6], v[7]);
        o1.x = pk2(v[8], v[9]); o1.y = pk2(v[10], v[11]); o1.z = pk2(v[12], v[13]); o1.w = pk2(v[14], v[15]);
        *(LAS v4u*)(dst + d * TP + 16 * tq) = o0; *(LAS v4u*)(dst + d * TP + 16 * tq + 8) = o1;
    } else {
#pragma unroll
        for (int u = 0; u < 16; ++u) dst[(16 * tq + u) * NP + d] = (bf16)f2bf(v[u]);
    }
}

__device__ __forceinline__ void ml_local(const Frame& F, int b, int ch, int r) {
    LAS bf16* T = (LAS bf16*)F.lds;
    LAS float* kw = (LAS float*)(F.lds + SM_OFF_BYTES);
    const float* gates = (const float*)(F.ws + WS_GATES);
    const int l = F.lane, q = l >> 4, r16 = l & 15;
    if (F.wave < 2) {
        const int hh = 2 * r + F.wave, item = (b * NH + hh) * NCH + ch;
        const int m = b * SEQ + ch * CL + l;
        const float li = gates[(size_t)m * 8 + hh] + F.in[12][hh];
        const float lf = logsigmoidf_(gates[(size_t)m * 8 + 4 + hh] + F.in[13][hh]);
        float bc = lf;
#pragma unroll
        for (int o = 1; o < 64; o <<= 1) { const float t = __shfl_up(bc, o); if (l >= o) bc += t; }
        const float blast = __shfl(bc, 63);
        const float w = blast - bc + li;
        const float mloc = wave_max(w);
        kw[F.wave * 64 + l] = __expf(w - mloc);
        if (l == 0) { ((float*)(F.ws + WS_MLOC))[item] = mloc; ((float*)(F.ws + WS_BLAST))[item] = blast; }
    }
    __syncthreads();
#pragma unroll
    for (int hl = 0; hl < 2; ++hl) { const int hh = 2 * r + hl;
        ml_stage<true, true, true>(F, b, ch, 1536 + hh * HD, 512 + hh * HD, 1.f, kw + hl * 64, T + hl * SLOT_A);
        ml_stage<false, false, true>(F, b, ch, 2048 + hh * HD, 0, 1.f, kw, T + hl * SLOT_A + T_TR); }
    __syncthreads();
    {
        const int hl = F.wave >> 2, part = F.wave & 3, hh = 2 * r + hl, item = (b * NH + hh) * NCH + ch;
        const LAS bf16* KT = T + hl * SLOT_A; const LAS bf16* VT = KT + T_TR;
        f32x4 acc[2][8];
#pragma unroll
        for (int mi = 0; mi < 2; ++mi)
#pragma unroll
            for (int n = 0; n < 8; ++n) acc[mi][n] = (f32x4){0.f, 0.f, 0.f, 0.f};
#pragma unroll
        for (int kk = 0; kk < 2; ++kk) {
            bf16x8 af[2];
#pragma unroll
            for (int mi = 0; mi < 2; ++mi) af[mi] = *(const LAS bf16x8*)(KT + (16 * (2 * part + mi) + r16) * TP + 32 * kk + 8 * q);
#pragma unroll
            for (int n = 0; n < 8; ++n) {
                const bf16x8 bv = *(const LAS bf16x8*)(VT + (16 * n + r16) * TP + 32 * kk + 8 * q);
#pragma unroll
                for (int mi = 0; mi < 2; ++mi) acc[mi][n] = MFMA16(af[mi], bv, acc[mi][n]);
            }
        }
        float* base = (float*)(F.ws + WS_CLOC) + (size_t)item * CITEM;
#pragma unroll
        for (int mi = 0; mi < 2; ++mi)
#pragma unroll
            for (int n = 0; n < 8; ++n) *(f32x4*)(base + (16 * n + r16) * HD + 16 * (2 * part + mi) + 4 * q) = acc[mi][n];
    }
    if (F.tid < 256) {
        const int hl = F.tid >> 7, d = F.tid & 127, hh = 2 * r + hl, item = (b * NH + hh) * NCH + ch;
        const LAS bf16* KT = T + hl * SLOT_A;
        float s = 0.f;
#pragma unroll
        for (int k8 = 0; k8 < 8; ++k8) { const v4u w = *(const LAS v4u*)(KT + d * TP + 8 * k8); const f32x4 a = unpk_lo(w), c = unpk_hi(w); s += (a.x + a.y) + (a.z + a.w) + (c.x + c.y) + (c.z + c.w); }
        ((float*)(F.ws + WS_CLOC))[(size_t)item * CITEM + HD * HD + d] = s;
    }
    __syncthreads();
}

__device__ __forceinline__ void ml_out(const Frame& F, int b, int ch, int r) {
    LAS bf16* T = (LAS bf16*)F.lds;
    LAS float* small = (LAS float*)(F.lds + SM_OFF_BYTES);
    const float* gates = (const float*)(F.ws + WS_GATES);
    const int l = F.lane, q = l >> 4, r16 = l & 15;
    const size_t row0 = (size_t)(b * SEQ + ch * CL);
    if (F.wave < 2) {
        const int hh = 2 * r + F.wave, item = (b * NH + hh) * NCH + ch;
        const float mprev = ((const float*)(F.ws + WS_MPREV))[item];
        const int m = b * SEQ + ch * CL + l;
        const float li = gates[(size_t)m * 8 + hh] + F.in[12][hh];
        const float lf = logsigmoidf_(gates[(size_t)m * 8 + 4 + hh] + F.in[13][hh]);
        float bc = lf;
#pragma unroll
        for (int o = 1; o < 64; o <<= 1) { const float t = __shfl_up(bc, o); if (l >= o) bc += t; }
        float gm = li - bc;
        const float gj = gm;
#pragma unroll
        for (int o = 1; o < 64; o <<= 1) { const float t = __shfl_up(gm, o); if (l >= o) gm = fmaxf(gm, t); }
        const float ms = bc + fmaxf(mprev, gm);
        LAS float* sm = small + F.wave * 256;
        sm[l] = gj; sm[64 + l] = bc - ms; sm[128 + l] = __expf(bc + mprev - ms); sm[192 + l] = __expf(-ms);
    }
#pragma unroll
    for (int hl = 0; hl < 2; ++hl) { const int hh = 2 * r + hl;
        ml_stage<true, false, false>(F, b, ch, 1024 + hh * HD, hh * HD, 0.08838834764831845f, small, T + hl * SLOT_C);
        ml_stage<true, false, false>(F, b, ch, 1536 + hh * HD, 512 + hh * HD, 1.f, small, T + hl * SLOT_C + T_NAT);
        ml_stage<false, false, true>(F, b, ch, 2048 + hh * HD, 0, 1.f, small, T + hl * SLOT_C + 2 * T_NAT); }
    __syncthreads();
    {
        const int hl = F.wave >> 2, sb = F.wave & 3, hh = 2 * r + hl, item = (b * NH + hh) * NCH + ch;
        const LAS bf16* QN = T + hl * SLOT_C; const LAS bf16* KN = QN + T_NAT; const LAS bf16* VT = QN + 2 * T_NAT;
        const LAS float* sm = small + hl * 256;
        const int s = 16 * sb + r16;
        const float* ct = (const float*)(F.ws + WS_CLOC) + (size_t)item * CITEM;
        bf16x8 qf[4];
#pragma unroll
        for (int kk = 0; kk < 4; ++kk) qf[kk] = *(const LAS bf16x8*)(QN + s * NP + 32 * kk + 8 * q);
        f32x4 acc[8];
#pragma unroll
        for (int me = 0; me < 8; ++me) {
            acc[me] = (f32x4){0.f, 0.f, 0.f, 0.f};
#pragma unroll
            for (int kk = 0; kk < 4; ++kk) { const float* p = ct + (16 * me + r16) * HD + 32 * kk + 8 * q;
                acc[me] = MFMA16(pack8(*(const f32x4*)p, *(const f32x4*)(p + 4)), qf[kk], acc[me]); }
        }
        f32x4 accn = (f32x4){0.f, 0.f, 0.f, 0.f};
#pragma unroll
        for (int kk = 0; kk < 4; ++kk) { const float* p = ct + HD * HD + 32 * kk + 8 * q;
            f32x4 lo = *(const f32x4*)p, hi = *(const f32x4*)(p + 4);
            if (r16 != 0) { lo = (f32x4){0.f, 0.f, 0.f, 0.f}; hi = lo; }
            accn = MFMA16(pack8(lo, hi), qf[kk], accn); }
        const float qn = __shfl(accn[0], r16);
        const float iw = sm[128 + s];
#pragma unroll
        for (int me = 0; me < 8; ++me) acc[me] = acc[me] * iw;
        f32x4 S[4];
#pragma unroll
        for (int m = 0; m < 4; ++m) {
            S[m] = (f32x4){0.f, 0.f, 0.f, 0.f};
            if (m <= sb) {
#pragma unroll
                for (int kk = 0; kk < 4; ++kk) S[m] = MFMA16(*(const LAS bf16x8*)(KN + (16 * m + r16) * NP + 32 * kk + 8 * q), qf[kk], S[m]);
            }
        }
        const float bs = sm[64 + s];
        float rs = 0.f;
#pragma unroll
        for (int m = 0; m < 4; ++m) {
            if (m <= sb) {
                const f32x4 gj = *(const LAS f32x4*)(sm + 16 * m + 4 * q);
#pragma unroll
                for (int i = 0; i < 4; ++i) { const int j = 16 * m + 4 * q + i; const float p = (j <= s) ? __expf(bs + gj[i]) : 0.f; S[m][i] *= p; rs += S[m][i]; }
            }
        }
        rs += __shfl_xor(rs, 16); rs += __shfl_xor(rs, 32);
        const float dn = fmaxf(fabsf(rs + iw * qn), sm[192 + s]);
#pragma unroll
        for (int k2 = 0; k2 < 2; ++k2) {
            if (2 * k2 <= sb) {
                const bf16x8 pf = pack8(S[2 * k2], S[2 * k2 + 1]);
#pragma unroll
                for (int me = 0; me < 8; ++me) { const LAS bf16* vp = VT + (16 * me + r16) * TP + 32 * k2 + 4 * q;
                    const v2u va = *(const LAS v2u*)vp, vb = *(const LAS v2u*)(vp + 16);
                    const v4u vv = (v4u){va.x, va.y, vb.x, vb.y};
                    acc[me] = MFMA16(__builtin_bit_cast(bf16x8, vv), pf, acc[me]); }
            }
        }
        const bf16* proj = (const bf16*)(F.ws + WS_PROJ);
        bf16* Y = (bf16*)(F.ws + WS_XN);
        const float rdn = 1.f / dn;
        float ss = 0.f;
#pragma unroll
        for (int me = 0; me < 8; ++me) {
            const v2u ow = *(const v2u*)(proj + (row0 + s) * NPROJ + 2560 + hh * HD + 16 * me + 4 * q);
            const f32x4 og = unpk2(ow);
            f32x4 o; o.x = sigmoidf_(og.x); o.y = sigmoidf_(og.y); o.z = sigmoidf_(og.z); o.w = sigmoidf_(og.w);
            acc[me] = o * (acc[me] * rdn);
            ss += (acc[me].x * acc[me].x + acc[me].y * acc[me].y) + (acc[me].z * acc[me].z + acc[me].w * acc[me].w);
        }
        ss += __shfl_xor(ss, 16); ss += __shfl_xor(ss, 32);
        const float rstd = rsqrtf(ss * (1.f / HD) + EPS);
#pragma unroll
        for (int me = 0; me < 8; ++me) {
            const f32x4 gn = *(const f32x4*)(F.in[15] + hh * HD + 16 * me + 4 * q);
            const f32x4 y = acc[me] * rstd * gn;
            v2u w; w.x = pk2(y.x, y.y); w.y = pk2(y.z, y.w);
            *(v2u*)(Y + (row0 + s) * DM + DRG + hh * HD + 16 * me + 4 * q) = w;
        }
    }
    __syncthreads();
}

__device__ __forceinline__ void scan_phase(const Frame& F) {
    LAS float* L = (LAS float*)F.lds;
    LAS float* so = L; LAS float* sn = L + 1024;
    if (F.tid < 32) {
        const int bh = F.tid; float m = 0.f;
        const float* mloc = (const float*)(F.ws + WS_MLOC); const float* blast = (const float*)(F.ws + WS_BLAST); float* mprev = (float*)(F.ws + WS_MPREV);
        for (int c = 0; c < NCH; ++c) {
            const float ml = mloc[bh * NCH + c], bl = blast[bh * NCH + c];
            const float mn = fmaxf(bl + m, ml);
            so[bh * NCH + c] = __expf(bl + m - mn); sn[bh * NCH + c] = __expf(ml - mn);
            if (F.bid == 0) mprev[bh * NCH + c] = m;
            m = mn;
        }
    }
    __syncthreads();
    const int gt = F.bid * NTHR + F.tid, NGT = F.G * NTHR;
    constexpr int V4_PER_BH = CITEM / 4;
    for (int idx = gt; idx < 32 * V4_PER_BH; idx += NGT) {
        const int bh = idx / V4_PER_BH, off = idx % V4_PER_BH;
        f32x4* p = (f32x4*)((float*)(F.ws + WS_CLOC) + (size_t)bh * NCH * CITEM) + off;
        f32x4 st = (f32x4){0.f, 0.f, 0.f, 0.f};
#pragma unroll 8
        for (int c = 0; c < NCH; ++c) {
            const f32x4 cl = p[(size_t)c * V4_PER_BH];
            p[(size_t)c * V4_PER_BH] = st;
            st = so[bh * NCH + c] * st + sn[bh * NCH + c] * cl;
        }
    }
    if (gt < NB * DRG) {
        const int b = gt / DRG, c = gt % DRG;
        const float* A = (const float*)(F.ws + WS_RGA); const float* H = (const float*)(F.ws + WS_RGH); float* HI = (float*)(F.ws + WS_RGIN);
        float h = 0.f;
#pragma unroll 8
        for (int k = 0; k < NCH; ++k) { const int o = (b * NCH + k) * DRG + c; const float a = A[o], hh = H[o]; HI[o] = h; h = a * h + hh; }
    }
    __syncthreads();
}

__device__ __forceinline__ void norm1_phase(const Frame& F) {
    const int gw = F.bid * NWAVES + F.wave, NGW = F.G * NWAVES;
    const float* mix = (const float*)(F.ws + WS_CLOC); bf16* V = (bf16*)(F.ws + WS_PROJ);
    f32x4 g1[4], g2[4];
#pragma unroll
    for (int j = 0; j < 4; ++j) { g1[j] = *(const f32x4*)(F.in[17] + 256 * j + 4 * F.lane); g2[j] = *(const f32x4*)(F.in[18] + 256 * j + 4 * F.lane); }
    for (int m = gw; m < MT; m += NGW) {
        const f32x4* mr = (const f32x4*)(mix + (size_t)m * DM) + F.lane; const f32x4* xr = (const f32x4*)(F.in[0] + (size_t)m * DM) + F.lane;
        f32x4 v[4], xv[4]; float s = 0.f;
#pragma unroll
        for (int j = 0; j < 4; ++j) { v[j] = mr[64 * j]; xv[j] = xr[64 * j]; s += (v[j].x * v[j].x + v[j].y * v[j].y) + (v[j].z * v[j].z + v[j].w * v[j].w); }
        const float rstd = rsqrtf(wave_sum(s) * (1.f / DM) + EPS);
        float s2 = 0.f;
        f32x4* orow = (f32x4*)(F.out + (size_t)m * DM) + F.lane;
#pragma unroll
        for (int j = 0; j < 4; ++j) { v[j] = xv[j] + v[j] * rstd * g1[j]; orow[64 * j] = v[j]; s2 += (v[j].x * v[j].x + v[j].y * v[j].y) + (v[j].z * v[j].z + v[j].w * v[j].w); }
        const float rstd2 = rsqrtf(wave_sum(s2) * (1.f / DM) + EPS);
        unsigned long long* o8 = (unsigned long long*)(V + (size_t)m * DM) + F.lane;
#pragma unroll
        for (int j = 0; j < 4; ++j) { const f32x4 y = v[j] * rstd2 * g2[j]; o8[64 * j] = (unsigned long long)pk2(y.x, y.y) | ((unsigned long long)pk2(y.z, y.w) << 32); }
    }
}
__device__ __forceinline__ void norm2_phase(const Frame& F) {
    const int gw = F.bid * NWAVES + F.wave, NGW = F.G * NWAVES;
    const float* ffo = (const float*)(F.ws + WS_FFO);
    f32x4 g1[4];
#pragma unroll
    for (int j = 0; j < 4; ++j) g1[j] = *(const f32x4*)(F.in[21] + 256 * j + 4 * F.lane);
    for (int m = gw; m < MT; m += NGW) {
        const f32x4* mr = (const f32x4*)(ffo + (size_t)m * DM) + F.lane; f32x4* orow = (f32x4*)(F.out + (size_t)m * DM) + F.lane;
        f32x4 v[4], xv[4]; float s = 0.f;
#pragma unroll
        for (int j = 0; j < 4; ++j) { v[j] = mr[64 * j]; xv[j] = orow[64 * j]; s += (v[j].x * v[j].x + v[j].y * v[j].y) + (v[j].z * v[j].z + v[j].w * v[j].w); }
        const float rstd = rsqrtf(wave_sum(s) * (1.f / DM) + EPS);
#pragma unroll
        for (int j = 0; j < 4; ++j) orow[64 * j] = xv[j] + v[j] * rstd * g1[j];
    }
}

#define XB_TMO      128
#define XB_XCNT(j)  (256  + 64 * (j))
#define XB_XSUB(j)  (1280 + 64 * (j))
#define XB_XGEN(j)  (2304 + 64 * (j))
#define XB_TOP      3328
#define XB_TOPGEN   3392
#define XCD_BAR_WORDS 3456
#define XB_SPIN_CAP (1u << 18)

__device__ __forceinline__ unsigned xb_ld(unsigned* p)              { return __hip_atomic_load(p, __ATOMIC_RELAXED, __HIP_MEMORY_SCOPE_AGENT); }
__device__ __forceinline__ unsigned xb_add(unsigned* p, unsigned v) { return __hip_atomic_fetch_add(p, v, __ATOMIC_RELAXED, __HIP_MEMORY_SCOPE_AGENT); }
__device__ __forceinline__ unsigned xb_xcc_id() { return (unsigned)__builtin_amdgcn_s_getreg((3 << 11) | 20) & 0xFu; }
#define XB_SPIN(cond, bar) do { unsigned _sp = 0; while (cond) { __builtin_amdgcn_s_sleep(1); \
    if ((++_sp & 255u) == 0u) { if (xb_ld(&(bar)[XB_TMO])) break; if (_sp > XB_SPIN_CAP) { atomicAdd(&(bar)[XB_TMO], 1u); break; } } } } while (0)

struct XcdBarrier {
    unsigned* bar; unsigned x;
    volatile LAS unsigned* st;
};

__device__ __forceinline__ XcdBarrier xcd_barrier_post(unsigned* bar, volatile LAS unsigned* st) {
    XcdBarrier b; b.bar = bar; b.x = xb_xcc_id(); b.st = st;
    if (threadIdx.x == 0) (void)xb_add(&bar[XB_XCNT(b.x)], 1u);
    return b;
}
__device__ __forceinline__ void xcd_barrier_complete(unsigned* bar, unsigned x, unsigned& nloc, unsigned& nx) {
    const unsigned G = gridDim.x * gridDim.y * gridDim.z;
    unsigned sum, cnt, mine, sp = 0u;
    for (;;) {
        sum = 0u; cnt = 0u; mine = 0u;
#pragma unroll
        for (unsigned j = 0; j < 16; ++j) { const unsigned c = xb_ld(&bar[XB_XCNT(j)]); sum += c; cnt += (c > 0u) ? 1u : 0u; mine = (j == x) ? c : mine; }
        if (sum == G) break;
        __builtin_amdgcn_s_sleep(1);
        if ((++sp & 255u) == 0u) { if (xb_ld(&bar[XB_TMO])) break; if (sp > XB_SPIN_CAP) { atomicAdd(&bar[XB_TMO], 1u); break; } }
    }
    nloc = mine > 0u ? mine : 1u; nx = cnt > 0u ? cnt : 1u;
}

__device__ __forceinline__ void xcd_barrier(const XcdBarrier& b) {
    asm volatile("s_waitcnt vmcnt(0)" ::: "memory");
    __syncthreads();
    if (threadIdx.x == 0) {
        unsigned* bar = b.bar;
        __builtin_amdgcn_s_waitcnt(0);
        unsigned nloc = b.st[0], nx = b.st[1];
        if (nloc == 0u) { xcd_barrier_complete(bar, b.x, nloc, nx); b.st[0] = nloc; b.st[1] = nx; }
        const unsigned old = xb_add(&bar[XB_XSUB(b.x)], 1u);
        const unsigned gen = old / nloc;
        if (old + 1u == (gen + 1u) * nloc) {
            __builtin_amdgcn_fence(__ATOMIC_RELEASE, "agent");
            asm volatile("s_waitcnt vmcnt(0)" ::: "memory");
            const unsigned og = xb_add(&bar[XB_TOP], 1u);
            const unsigned tg = og / nx;
            if (og + 1u == (tg + 1u) * nx) xb_add(&bar[XB_TOPGEN], 1u);
            else XB_SPIN(xb_ld(&bar[XB_TOPGEN]) == tg, bar);
            __builtin_amdgcn_fence(__ATOMIC_ACQUIRE, "agent");
            xb_add(&bar[XB_XGEN(b.x)], 1u);
            asm volatile("s_waitcnt vmcnt(0)" ::: "memory");
        } else {
            XB_SPIN(xb_ld(&bar[XB_XGEN(b.x)]) == gen, bar);
            __builtin_amdgcn_fence(__ATOMIC_ACQUIRE, "agent");
            asm volatile("s_waitcnt vmcnt(0)" ::: "memory");
        }
    }
    __syncthreads();
}

struct Args { const float* in[22]; float* out; unsigned char* ws; };
__global__ void __launch_bounds__(NTHR, 2) hymba_fwd(Args args) {
    extern __shared__ __attribute__((aligned(16))) unsigned char lds[];
    cg::grid_group grid = cg::this_grid();
    Frame F;
    F.lds = (LAS unsigned char*)lds;
    F.tid = threadIdx.x; F.lane = F.tid & 63; F.wave = __builtin_amdgcn_readfirstlane(F.tid >> 6);
    F.G = gridDim.x; F.bid = blockIdx.x;
#pragma unroll
    for (int i = 0; i < 22; ++i) F.in[i] = args.in[i];
    F.out = args.out; F.ws = args.ws;
    bf16* XN = (bf16*)(F.ws + WS_XN); bf16* PROJ = (bf16*)(F.ws + WS_PROJ);

    volatile LAS unsigned* MISC = (volatile LAS unsigned*)(F.lds + 143360);
    if (F.tid < 2) MISC[F.tid] = 0u;
    unsigned* barw = (unsigned*)F.ws;
    if (F.bid == 0) for (int i = F.tid; i < XCD_BAR_WORDS; i += NTHR) __hip_atomic_store(barw + i, 0u, __ATOMIC_RELAXED, __HIP_MEMORY_SCOPE_AGENT);
    __syncthreads();
#ifndef SKIP_P0
    p0_prologue(F);
#endif
    grid.sync();
    const XcdBarrier bar = xcd_barrier_post(barw, MISC);
    { pg8::Gemm g{XN, (const bf16*)(F.ws + WS_WIN), MT, NPROJ, DM}; pg8::StaticOrder S; S.init(MT, NPROJ, F.G, F.bid);
      pg8::EpiBf16<0> E{PROJ, NPROJ};
      pg8::gemm_phase<pg8::EpiBf16<0>, pg8::StaticOrder, true, true>(F.lds, g, S, E); }
    xcd_barrier(bar);
    if (F.bid < NB * NCH) { const int it = F.bid; const int b = it / NCH, ch = it % NCH;
#ifndef SKIP_RG
        rg_pass<false>(F, b, ch);
#endif
#pragma unroll 1
        for (int r = 0; r < 2; ++r) {
#ifndef SKIP_MLA
            ml_local(F, b, ch, r);
#endif
        } }
    xcd_barrier(bar);
#ifndef SKIP_SCAN
    scan_phase(F);
#endif
    xcd_barrier(bar);
    if (F.bid < NB * NCH) { const int it = F.bid; const int b = it / NCH, ch = it % NCH;
#ifndef SKIP_RG
        rg_pass<true>(F, b, ch);
#endif
#pragma unroll 1
        for (int r = 0; r < 2; ++r) {
#ifndef SKIP_MLC
            ml_out(F, b, ch, r);
#endif
        } }
    xcd_barrier(bar);
    { pg8::Gemm g{XN, (const bf16*)(F.ws + WS_WO), MT, DM, DM}; pg8::StaticOrder S; S.init(MT, DM, F.G, F.bid);
      pg8::EpiF32 E{(float*)(F.ws + WS_CLOC), DM};
      pg8::gemm_phase<pg8::EpiF32, pg8::StaticOrder, true, true>(F.lds, g, S, E); }
    xcd_barrier(bar);
    norm1_phase(F);
    xcd_barrier(bar);
    { pg8::Gemm g{PROJ, (const bf16*)(F.ws + WS_WUP), MT, FF, DM}; pg8::StaticOrder S; S.init(MT, FF, F.G, F.bid);
      pg8::EpiBf16<2> E{(bf16*)(F.ws + WS_H), FF};
      pg8::gemm_phase<pg8::EpiBf16<2>, pg8::StaticOrder, true, true>(F.lds, g, S, E); }
    xcd_barrier(bar);
    { pg8::Gemm g{(const bf16*)(F.ws + WS_H), (const bf16*)(F.ws + WS_WDN), MT, DM, FF}; pg8::StaticOrder S; S.init(MT, DM, F.G, F.bid);
      pg8::EpiF32 E{(float*)(F.ws + WS_FFO), DM};
      pg8::gemm_phase<pg8::EpiF32, pg8::StaticOrder, true, true>(F.lds, g, S, E); }
    xcd_barrier(bar);
    norm2_phase(F);
}

extern "C" void kernel_launch(void* const* d_in, const int* in_sizes, int n_in, void* d_out, int out_size, void* d_ws, size_t ws_size, hipStream_t stream) {
    static int grid = 0;
    if (grid == 0) {
        int dev = 0, cus = 0, per_cu = 0;
        hipGetDevice(&dev);
        hipDeviceGetAttribute(&cus, hipDeviceAttributeMultiprocessorCount, dev);
        hipFuncSetAttribute((const void*)hymba_fwd, hipFuncAttributeMaxDynamicSharedMemorySize, LDS_BYTES);
        hipOccupancyMaxActiveBlocksPerMultiprocessor(&per_cu, (const void*)hymba_fwd, NTHR, LDS_BYTES);
        if (per_cu < 1) { fprintf(stderr, "kernel_launch: occupancy query says %d blocks per CU\n", per_cu); per_cu = 1; }
        grid = cus;
        if (n_in != 22 || out_size != MT * DM || ws_size < 256 * MiB) fprintf(stderr, "kernel_launch: unexpected shapes n_in %d out %d ws %zu\n", n_in, out_size, ws_size);
    }
    Args a{};
    for (int i = 0; i < 22; ++i) a.in[i] = (const float*)d_in[i];
    a.out = (float*)d_out; a.ws = (unsigned char*)d_ws;
    void* kargs[] = {&a};
    hipError_t e = hipLaunchCooperativeKernel((const void*)hymba_fwd, dim3(grid), dim3(NTHR), kargs, LDS_BYTES, stream);
    if (e != hipSuccess) fprintf(stderr, "cooperative launch failed: %s (grid %d)\n", hipGetErrorString(e), grid);
}
```
